# Optimizing an MI355X kernel written in HIP

```python
import math
import jax, jax.numpy as jnp
from jax import lax
import numpy as np

D_MODEL = 1024
BATCH = 32
SEQ = 256
DEPTH = 1
DEC_BATCH = 8
DEC_SEQ = 1024
PAST_LEN = 256

GRID_W = 64
A_WIDTH = D_MODEL // 2
B_WIDTH = D_MODEL - A_WIDTH
H_A = 4
DV_A = A_WIDTH // H_A
DK_A = DV_A // 2
H_B = 4
DV_B = B_WIDTH // H_B
DK_B = DV_B // 2
GATE_RANK = 16
GATE_NORM = 16.0
GLA_CHUNK = 64
D_FF = 4 * D_MODEL
N_MOD = 6
Q_BLOCK = 128
ROPE_BASE = 10000.0
EPS = 1e-6

kernel_name = "hybrid_diffattn_gla_prefix_dit_step"


def rmsnorm(x, g):
    xf = x.astype(jnp.float32)
    y = xf * lax.rsqrt(jnp.mean(xf * xf, axis=-1, keepdims=True) + EPS)
    return (y * g.astype(jnp.float32)).astype(x.dtype)


def rope_1d(x, pos):
    half = x.shape[-1] // 2
    inv = ROPE_BASE ** (-jnp.arange(half, dtype=jnp.float32) / half)
    ang = pos.astype(jnp.float32)[:, None] * inv[None, :]
    cos, sin = jnp.cos(ang).astype(x.dtype), jnp.sin(ang).astype(x.dtype)
    x1, x2 = x[..., :half], x[..., half:]
    return jnp.concatenate([x1 * cos - x2 * sin, x1 * sin + x2 * cos], axis=-1)


def rope2d(x, row_pos, col_pos):
    d = x.shape[-1] // 2
    return jnp.concatenate([rope_1d(x[..., :d], row_pos), rope_1d(x[..., d:], col_pos)], axis=-1)


def diff_attention(q1, q2, k1, k2, v, lam):
    B, H, Lq, d = q1.shape
    nb = Lq // Q_BLOCK
    scale = d ** -0.5

    def to_blocks(q):
        return jnp.moveaxis(q.reshape(B, H, nb, Q_BLOCK, d), 2, 0)

    def one_block(qs):
        a1, a2 = qs
        s1 = jnp.einsum('bhqd,bhkd->bhqk', a1, k1).astype(jnp.float32) * scale
        s2 = jnp.einsum('bhqd,bhkd->bhqk', a2, k2).astype(jnp.float32) * scale
        p = jax.nn.softmax(s1, axis=-1) - lam * jax.nn.softmax(s2, axis=-1)
        return jnp.einsum('bhqk,bhkv->bhqv', p.astype(v.dtype), v)

    o = lax.map(one_block, (to_blocks(q1), to_blocks(q2)))
    return jnp.moveaxis(o, 0, 2).reshape(B, H, Lq, v.shape[-1])


def gla_scan(q, k, v, g, s0):
    B, H, L, dk = q.shape
    dv = v.shape[-1]
    n = L // GLA_CHUNK

    def chunks(t):
        return jnp.moveaxis(t.astype(jnp.float32).reshape(B, H, n, GLA_CHUNK, t.shape[-1]), 2, 0)

    causal = jnp.tril(jnp.ones((GLA_CHUNK, GLA_CHUNK), dtype=bool))[:, :, None]

    def step(S, inp):
        qc, kc, vc, gc = inp
        b = jnp.cumsum(gc, axis=-2)
        o_inter = jnp.einsum('bhtk,bhkv->bhtv', qc * jnp.exp(b), S)
        diff = b[..., :, None, :] - b[..., None, :, :]
        decay = jnp.where(causal, jnp.exp(jnp.where(causal, diff, 0.0)), 0.0)
        att = jnp.einsum('bhtk,bhsk,bhtsk->bhts', qc, kc, decay)
        o = o_inter + jnp.einsum('bhts,bhsv->bhtv', att, vc)
        b_last = b[..., -1:, :]
        S_new = jnp.exp(b_last)[..., 0, :, None] * S + jnp.einsum('bhsk,bhsv->bhkv', kc * jnp.exp(b_last - b), vc)
        return S_new, o

    S_fin, o = lax.scan(step, s0.astype(jnp.float32), (chunks(q), chunks(k), chunks(v), chunks(g)))
    return jnp.moveaxis(o, 0, 2).reshape(B, H, L, dv), S_fin


def adaln(cvec, lw):
    m = jax.nn.silu(cvec) @ lw['w_ada'] + lw['b_ada']
    return [t[:, None, :] for t in jnp.split(m, N_MOD, axis=-1)]


def token_mixers(h, lw, lam_init, pos, ctx_k, ctx_v, s0_f, s0_b):
    B, L, _ = h.shape
    sizes = [H_A * 2 * DK_A, H_A * 2 * DK_A, H_A * DV_A, H_B * DK_B, H_B * DK_B,
             H_B * DV_B, H_B * DV_B, GATE_RANK, GATE_RANK]
    cuts = [int(s) for s in np.cumsum(sizes)[:-1]]
    qa, ka, va, qb, kb, vb, rb, glf, glb = jnp.split(h @ lw['w_in'], cuts, axis=-1)

    def heads(t, nh):
        return t.reshape(B, L, nh, -1).transpose(0, 2, 1, 3)

    qa, ka, va = heads(qa, H_A), heads(ka, H_A), heads(va, H_A)
    q1, q2, k1, k2 = qa[..., :DK_A], qa[..., DK_A:], ka[..., :DK_A], ka[..., DK_A:]
    if pos is not None:
        row_pos, col_pos = pos
        q1, q2, k1, k2 = (rope2d(t, row_pos, col_pos) for t in (q1, q2, k1, k2))
    own_k = jnp.concatenate([k1, k2], axis=-1)
    if ctx_k is not None:
        keys = jnp.concatenate([ctx_k, own_k], axis=2)
        values = jnp.concatenate([ctx_v, va], axis=2)
    else:
        keys, values = own_k, va
    f32 = jnp.float32
    lam = (jnp.exp(jnp.sum(lw['lam_q1'].astype(f32) * lw['lam_k1'].astype(f32)))
           - jnp.exp(jnp.sum(lw['lam_q2'].astype(f32) * lw['lam_k2'].astype(f32))) + lam_init)
    o_a = diff_attention(q1, q2, keys[..., :DK_A], keys[..., DK_A:], values, lam)
    o_a = rmsnorm(o_a, lw['diff_norm']) * (1.0 - lam_init)
    o_a = o_a.transpose(0, 2, 1, 3).reshape(B, L, H_A * DV_A)

    qb = heads(qb, H_B) * (DK_B ** -0.5)
    kb, vb = heads(kb, H_B), heads(vb, H_B)
    g_f = heads(jax.nn.log_sigmoid((glf @ lw['w_gate_fwd'] + lw['b_gate_fwd']).astype(f32)) / GATE_NORM, H_B)
    g_b = heads(jax.nn.log_sigmoid((glb @ lw['w_gate_bwd'] + lw['b_gate_bwd']).astype(f32)) / GATE_NORM, H_B)
    if s0_f is None:
        s0_f = jnp.zeros((B, H_B, DK_B, DV_B), f32)
        s0_b = jnp.zeros((B, H_B, DK_B, DV_B), f32)
    o_f, s_f = gla_scan(qb, kb, vb, g_f, s0_f)
    flip = lambda t: jnp.flip(t, axis=2)
    o_b, s_b = gla_scan(flip(qb), flip(kb), flip(vb), flip(g_b), s0_b)
    o_g = rmsnorm(o_f + flip(o_b), lw['gla_norm'])
    o_g = (o_g.transpose(0, 2, 1, 3).reshape(B, L, H_B * DV_B) * jax.nn.silu(rb.astype(f32))).astype(h.dtype)

    out = jnp.concatenate([o_a, o_g], axis=-1) @ lw['w_out']
    return out, (own_k, va, s_f, s_b)


def layer(x, cvec, lw, lam_init, pos, ctx_k, ctx_v, s0_f, s0_b):
    shift1, scale1, gate1, shift2, scale2, gate2 = adaln(cvec, lw)
    h = rmsnorm(x, lw['norm_attn_pre']) * (1.0 + scale1) + shift1
    mix, ctx_tensors = token_mixers(h, lw, lam_init, pos, ctx_k, ctx_v, s0_f, s0_b)
    x = x + gate1 * rmsnorm(mix, lw['norm_attn_post'])
    h2 = rmsnorm(x, lw['norm_mlp_pre']) * (1.0 + scale2) + shift2
    f = jnp.square(jax.nn.relu(h2 @ lw['w_mlp1'])) @ lw['w_mlp2']
    x = x + gate2 * rmsnorm(f, lw['norm_mlp_post'])
    return x, ctx_tensors


def setup_inputs(seed: int = 0) -> dict:
    key = jax.random.key(seed)
    ks = jax.random.split(key, 32)
    nrm = lambda k, shape, s=1.0: jax.random.normal(k, shape, jnp.float32) * s
    gain = lambda k: 1.0 + nrm(k, (DEPTH, D_MODEL), 0.05)
    in_cols = 2 * H_A * 2 * DK_A + H_A * DV_A + 2 * H_B * DK_B + 2 * H_B * DV_B + 2 * GATE_RANK
    return {
        "x_prompt": nrm(ks[0], (BATCH, SEQ, D_MODEL)),
        "x_sample": nrm(ks[1], (DEC_BATCH, DEC_SEQ, D_MODEL)),
        "c": nrm(ks[2], (DEC_BATCH, D_MODEL)),
        "cache_k": nrm(ks[3], (DEC_BATCH, DEPTH, H_A, PAST_LEN, 2 * DK_A)),
        "cache_v": nrm(ks[4], (DEC_BATCH, DEPTH, H_A, PAST_LEN, DV_A)),
        "state_fwd": nrm(ks[5], (DEC_BATCH, DEPTH, H_B, DK_B, DV_B), 0.5),
        "state_bwd": nrm(ks[6], (DEC_BATCH, DEPTH, H_B, DK_B, DV_B), 0.5),
        "c_ctx": nrm(ks[7], (D_MODEL,)),
        "w_ada": nrm(ks[8], (DEPTH, D_MODEL, N_MOD * D_MODEL), 0.5 * D_MODEL ** -0.5),
        "b_ada": nrm(ks[9], (DEPTH, N_MOD * D_MODEL), 0.02),
        "norm_attn_pre": gain(ks[10]),
        "norm_attn_post": gain(ks[11]),
        "norm_mlp_pre": gain(ks[12]),
        "norm_mlp_post": gain(ks[13]),
        "w_in": nrm(ks[14], (DEPTH, D_MODEL, in_cols), D_MODEL ** -0.5),
        "w_gate_fwd": nrm(ks[15], (DEPTH, GATE_RANK, H_B * DK_B), GATE_RANK ** -0.5),
        "b_gate_fwd": nrm(ks[16], (DEPTH, H_B * DK_B), 0.1),
        "w_gate_bwd": nrm(ks[17], (DEPTH, GATE_RANK, H_B * DK_B), GATE_RANK ** -0.5),
        "b_gate_bwd": nrm(ks[18], (DEPTH, H_B * DK_B), 0.1),
        "lam_q1": nrm(ks[19], (DEPTH, DK_A), 0.1),
        "lam_k1": nrm(ks[20], (DEPTH, DK_A), 0.1),
        "lam_q2": nrm(ks[21], (DEPTH, DK_A), 0.1),
        "lam_k2": nrm(ks[22], (DEPTH, DK_A), 0.1),
        "diff_norm": 1.0 + nrm(ks[23], (DEPTH, DV_A), 0.05),
        "gla_norm": 1.0 + nrm(ks[24], (DEPTH, DV_B), 0.05),
        "w_out": nrm(ks[25], (DEPTH, D_MODEL, D_MODEL), D_MODEL ** -0.5),
        "w_mlp1": nrm(ks[26], (DEPTH, D_MODEL, D_FF), D_MODEL ** -0.5),
        "w_mlp2": nrm(ks[27], (DEPTH, D_FF, D_MODEL), D_FF ** -0.5),
    }


def reference(x_prompt, x_sample, c, cache_k, cache_v, state_fwd, state_bwd, c_ctx,
              w_ada, b_ada, norm_attn_pre, norm_attn_post, norm_mlp_pre, norm_mlp_post,
              w_in, w_gate_fwd, b_gate_fwd, w_gate_bwd, b_gate_bwd,
              lam_q1, lam_k1, lam_q2, lam_k2, diff_norm, gla_norm, w_out, w_mlp1, w_mlp2):
    n_lat = x_sample.shape[1]
    ROWS = n_lat // GRID_W
    row_pos = jnp.repeat(jnp.arange(ROWS, dtype=jnp.int32), GRID_W)
    col_pos = jnp.arange(ROWS * GRID_W, dtype=jnp.int32) % GRID_W
    pos = (row_pos, col_pos)

    y_prompt, y_sample = x_prompt, x_sample
    new_k, new_v, new_sf, new_sb = [], [], [], []
    for l in range(DEPTH):
        lw = {
            'w_ada': w_ada[l], 'b_ada': b_ada[l],
            'norm_attn_pre': norm_attn_pre[l], 'norm_attn_post': norm_attn_post[l],
            'norm_mlp_pre': norm_mlp_pre[l], 'norm_mlp_post': norm_mlp_post[l],
            'w_in': w_in[l], 'w_gate_fwd': w_gate_fwd[l], 'b_gate_fwd': b_gate_fwd[l],
            'w_gate_bwd': w_gate_bwd[l], 'b_gate_bwd': b_gate_bwd[l],
            'lam_q1': lam_q1[l], 'lam_k1': lam_k1[l], 'lam_q2': lam_q2[l], 'lam_k2': lam_k2[l],
            'diff_norm': diff_norm[l], 'gla_norm': gla_norm[l], 'w_out': w_out[l],
            'w_mlp1': w_mlp1[l], 'w_mlp2': w_mlp2[l],
        }
        lam_init = 0.8 - 0.6 * math.exp(-0.3 * l)
        y_prompt, (k_c, v_c, s_f, s_b) = layer(y_prompt, c_ctx[None, :], lw, lam_init,
                                                None, None, None, None, None)
        new_k.append(k_c)
        new_v.append(v_c)
        new_sf.append(s_f)
        new_sb.append(s_b)
        y_sample, _ = layer(y_sample, c, lw, lam_init, pos,
                            cache_k[:, l], cache_v[:, l], state_fwd[:, l], state_bwd[:, l])
    new_cache_k = jnp.stack(new_k, axis=1)
    new_cache_v = jnp.stack(new_v, axis=1)
    new_state_fwd = jnp.stack(new_sf, axis=1)
    new_state_bwd = jnp.stack(new_sb, axis=1)
    return (y_prompt, y_sample, new_cache_k, new_cache_v, new_state_fwd, new_state_bwd)
```

```cpp
#include <hip/hip_runtime.h>
#include <hip/hip_cooperative_groups.h>
#include <cstdio>
#include <cstdint>
#include <cmath>
namespace cg = cooperative_groups;
namespace pg8 {
#define PG8_LAS __attribute__((address_space(3)))
typedef unsigned short bf16_t;
typedef short bf16x8 __attribute__((ext_vector_type(8)));
typedef float f32x4 __attribute__((ext_vector_type(4)));
typedef unsigned u32x4 __attribute__((ext_vector_type(4)));
constexpr int BM = 256, BK = 64, HALF = 128, HTB = HALF * BK * 2  , STAGE_BYTES = 8 * HTB, NXCD = 8, WGM = 8;

__host__ __device__ __forceinline__ int lds_byte(int r, int c) { const int st = (r >> 4) * 2 + (c >> 5), rr = r & 15, cc = c & 31, ob = rr * 64 + cc * 2; return st * 1024 + (ob ^ (((ob >> 9) & 1) << 5)); }
__host__ __device__ __forceinline__ void stage_rc(int b, int& R, int& C) { const int st = b / 1024, sb = b % 1024, swz = sb ^ (((sb >> 9) & 1) << 5); R = (st >> 1) * 16 + swz / 64; C = (st & 1) * 32 + (swz % 64) / 2; }
__host__ __device__ __forceinline__ int perm32(int rho) { const int n = rho >> 4, i = rho & 15; return 8 * (i >> 2) + 4 * n + (i & 3); }

struct Unit { int pm, pn; };
struct Gemm { const bf16_t* A; const bf16_t* Bt; int M, N, K; };

struct StaticOrder {
    int nM, nN, nwg, G, c;
    __host__ __device__ void init(int M, int N, int G_, int c_) { nM = M / BM; nN = N / BM; nwg = nM * nN; G = G_; c = c_; }
    __host__ __device__ bool next(int i, Unit& u) const {
        const long L = (long)i * G + c; if (L >= nwg) return false;
        int wgid = (int)L; { const int q = nwg / NXCD, r = nwg % NXCD, xcd = wgid % NXCD, off = wgid / NXCD; wgid = (xcd < r ? xcd * (q + 1) : r * (q + 1) + (xcd - r) * q) + off; }
        const int nig = WGM * nN, gid = wgid / nig, fm = gid * WGM, gsz = (nM - fm) < WGM ? (nM - fm) : WGM;
        u.pm = fm + ((wgid % nig) % gsz); u.pn = (wgid % nig) / gsz; return true;
    }
    __device__ __forceinline__ void a_ready(const Unit&) const {}
    __device__ __forceinline__ void done(const Unit&) const {}
};

__device__ __forceinline__ unsigned cvt_pk_bf16(float lo, float hi) { unsigned r; asm volatile("v_cvt_pk_bf16_f32 %0, %1, %2" : "=v"(r) : "v"(lo), "v"(hi)); return r; }
typedef float f32x2 __attribute__((ext_vector_type(2)));
template <class Epi, class Sched, bool ALIGN_EPI = false, bool SP2 = false>
__device__ __forceinline__ void gemm_phase(PG8_LAS unsigned char* lds, const Gemm g, const Sched& S, const Epi& E) {
    const int tid = threadIdx.x, wid = __builtin_amdgcn_readfirstlane(tid >> 6), lane = tid & 63, wr = wid >> 2, wc = wid & 3, fr = lane & 15, fq = lane >> 4;
    const int K = g.K, nt = K / BK;
    unsigned voffA[2], voffB[2];
#pragma unroll
    for (int i = 0; i < 2; ++i) { int R, C; stage_rc(tid * 16 + i * 8192, R, C); const int Rb = Epi::PERM ? ((R & ~31) + perm32(R & 31)) : R;
        voffA[i] = (unsigned)(R * K + C) * 2u; voffB[i] = (unsigned)(Rb * K + C) * 2u; }
    const size_t kstep = (size_t)(BK * 2);
    const size_t hstep = (size_t)HALF * K * 2;
    const size_t tstep = 2 * hstep;
    const unsigned ldsw = (unsigned)wid * 1024u;
    const int aoff = lds_byte(wr * 64 + fr, fq * 8), boff = lds_byte(wc * 32 + fr, fq * 8);
#define PG8_SA(b, h) (((b) * 2 + (h)) * HTB)
#define PG8_SB(b, h) ((4 + (b) * 2 + (h)) * HTB)
#define PG8_STAGE(bufoff, gbase, voff) do { _Pragma("unroll") for (int _i = 0; _i < 2; ++_i) \
        __builtin_amdgcn_global_load_lds((const unsigned*)((const char*)(gbase) + (voff)[_i]), (PG8_LAS unsigned*)(lds + (bufoff) + ldsw + _i * 8192), 16, 0, 0); } while (0)
#define PG8_LDA(dst, b, h) do { _Pragma("unroll") for (int m = 0; m < 4; ++m) _Pragma("unroll") for (int k = 0; k < 2; ++k) dst[m][k] = *(const PG8_LAS bf16x8*)(lds + PG8_SA(b, h) + aoff + m * 2048 + k * 1024); } while (0)
#define PG8_LDB(dst, b, h) do { _Pragma("unroll") for (int n = 0; n < 2; ++n) _Pragma("unroll") for (int k = 0; k < 2; ++k) dst[n][k] = *(const PG8_LAS bf16x8*)(lds + PG8_SB(b, h) + boff + n * 2048 + k * 1024); } while (0)
#define PG8_MMA(ai, bj, At, Bt) do { __builtin_amdgcn_s_setprio(1); _Pragma("unroll") for (int m = 0; m < 4; ++m) _Pragma("unroll") for (int n = 0; n < 2; ++n) _Pragma("unroll") for (int k = 0; k < 2; ++k) \
        acc[ai][bj][m][n] = __builtin_amdgcn_mfma_f32_16x16x32_bf16(Bt[n][k], At[m][k], acc[ai][bj][m][n], 0, 0, 0); __builtin_amdgcn_s_setprio(0); } while (0)
#define PG8_WAIT_V(n) asm volatile("s_waitcnt vmcnt(" #n ")" ::: "memory")
#define PG8_WAIT_L(n) asm volatile("s_waitcnt lgkmcnt(" #n ")" ::: "memory")
#define PG8_BAR __builtin_amdgcn_s_barrier()
#define PG8_SCHED __builtin_amdgcn_sched_barrier(0)
    Unit cur, nxt; int ui = 0;
    if (!S.next(0, cur)) return;
    f32x4 acc[2][2][4][2];
#pragma unroll
    for (int a = 0; a < 2; ++a)
#pragma unroll
        for (int b = 0; b < 2; ++b)
#pragma unroll
            for (int m = 0; m < 4; ++m)
#pragma unroll
                for (int n = 0; n < 2; ++n) acc[a][b][m][n] = (f32x4){0.f, 0.f, 0.f, 0.f};
    bf16x8 At[4][2], B0[2][2], B1[2][2];
    const char* cA = (const char*)g.A + (size_t)cur.pm * tstep; const char* cB = (const char*)g.Bt + (size_t)cur.pn * tstep;
    S.a_ready(cur);
    if constexpr (SP2) {
        PG8_STAGE(PG8_SB(0, 0), cB, voffB); PG8_STAGE(PG8_SB(0, 1), cB + hstep, voffB); PG8_STAGE(PG8_SA(0, 0), cA, voffA); PG8_STAGE(PG8_SA(0, 1), cA + hstep, voffA);
        if (wr == 1) PG8_BAR;
        PG8_WAIT_V(2); PG8_BAR;
        PG8_STAGE(PG8_SB(1, 0), cB + kstep, voffB); PG8_STAGE(PG8_SA(1, 0), cA + kstep, voffA); PG8_STAGE(PG8_SB(1, 1), cB + hstep + kstep, voffB);
        PG8_WAIT_V(6); PG8_BAR;
    } else {
        PG8_STAGE(PG8_SB(0, 0), cB, voffB); PG8_STAGE(PG8_SA(0, 0), cA, voffA); PG8_STAGE(PG8_SB(0, 1), cB + hstep, voffB); PG8_STAGE(PG8_SA(0, 1), cA + hstep, voffA);
        if (wr == 1) PG8_BAR;
        PG8_WAIT_V(4); PG8_BAR;
        PG8_STAGE(PG8_SB(1, 0), cB + kstep, voffB); PG8_STAGE(PG8_SA(1, 0), cA + kstep, voffA); PG8_STAGE(PG8_SB(1, 1), cB + hstep + kstep, voffB);
        PG8_WAIT_V(6); PG8_BAR;
    }
    for (;;) {
        const bool has_next = S.next(ui + 1, nxt);
        const char* nA = has_next ? (const char*)g.A + (size_t)nxt.pm * tstep : cA; const char* nB = has_next ? (const char*)g.Bt + (size_t)nxt.pn * tstep : cB;
        for (int t = 0; t < nt; t += 2) {
            const bool last = (t == nt - 2);
            const char* a1 = cA + (size_t)(t + 1) * kstep;
            const char* a2 = last ? nA : cA + (size_t)(t + 2) * kstep; const char* b2 = last ? nB : cB + (size_t)(t + 2) * kstep;
            const char* a3 = a2 + kstep; const char* b3 = b2 + kstep;
            if (last && has_next) S.a_ready(nxt);
            if constexpr (SP2) {
            PG8_LDB(B0, 0, 0); PG8_LDB(B1, 0, 1); PG8_SCHED; PG8_LDA(At, 0, 0); PG8_STAGE(PG8_SA(1, 1), a1 + hstep, voffA);
            PG8_WAIT_V(8); PG8_WAIT_L(0); PG8_BAR; PG8_MMA(0, 0, At, B0); PG8_MMA(0, 1, At, B1); PG8_BAR; PG8_SCHED;
            PG8_LDA(At, 0, 1); PG8_STAGE(PG8_SB(0, 0), b2, voffB); PG8_STAGE(PG8_SB(0, 1), b2 + hstep, voffB); PG8_STAGE(PG8_SA(0, 0), a2, voffA);
            PG8_WAIT_V(8); PG8_WAIT_L(0); PG8_BAR; PG8_MMA(1, 0, At, B0); PG8_MMA(1, 1, At, B1); PG8_BAR; PG8_SCHED;
            PG8_LDB(B0, 1, 0); PG8_LDB(B1, 1, 1); PG8_SCHED; PG8_LDA(At, 1, 0); PG8_STAGE(PG8_SA(0, 1), a2 + hstep, voffA);
            PG8_WAIT_V(8); PG8_WAIT_L(0); PG8_BAR; PG8_MMA(0, 0, At, B0); PG8_MMA(0, 1, At, B1); PG8_BAR; PG8_SCHED;
            PG8_LDA(At, 1, 1); PG8_STAGE(PG8_SB(1, 0), b3, voffB); PG8_STAGE(PG8_SB(1, 1), b3 + hstep, voffB); PG8_STAGE(PG8_SA(1, 0), a3, voffA);
            PG8_WAIT_V(8); PG8_WAIT_L(0); PG8_BAR; PG8_MMA(1, 0, At, B0); PG8_MMA(1, 1, At, B1); PG8_BAR; PG8_SCHED;
            } else {
            PG8_LDB(B0, 0, 0); PG8_SCHED; PG8_LDA(At, 0, 0); PG8_STAGE(PG8_SA(1, 1), a1 + hstep, voffA);
            PG8_WAIT_L(8); PG8_BAR; PG8_WAIT_L(0); PG8_MMA(0, 0, At, B0); PG8_BAR; PG8_SCHED;
            PG8_LDB(B1, 0, 1); PG8_STAGE(PG8_SB(0, 0), b2, voffB);
            PG8_BAR; PG8_WAIT_L(0); PG8_MMA(0, 1, At, B1); PG8_BAR;
            PG8_LDA(At, 0, 1); PG8_STAGE(PG8_SA(0, 0), a2, voffA);
            PG8_BAR; PG8_WAIT_L(0); PG8_MMA(1, 0, At, B0); PG8_BAR; PG8_SCHED;
            PG8_STAGE(PG8_SB(0, 1), b2 + hstep, voffB);
            PG8_WAIT_V(6); PG8_BAR; PG8_MMA(1, 1, At, B1); PG8_BAR;
            PG8_LDB(B0, 1, 0); PG8_SCHED; PG8_LDA(At, 1, 0); PG8_STAGE(PG8_SA(0, 1), a2 + hstep, voffA);
            PG8_WAIT_L(8); PG8_BAR; PG8_WAIT_L(0); PG8_MMA(0, 0, At, B0); PG8_BAR; PG8_SCHED;
            PG8_LDB(B1, 1, 1); PG8_STAGE(PG8_SB(1, 0), b3, voffB);
            PG8_BAR; PG8_WAIT_L(0); PG8_MMA(0, 1, At, B1); PG8_BAR;
            PG8_LDA(At, 1, 1); PG8_STAGE(PG8_SA(1, 0), a3, voffA);
            PG8_BAR; PG8_WAIT_L(0); PG8_MMA(1, 0, At, B0); PG8_BAR; PG8_SCHED;
            PG8_STAGE(PG8_SB(1, 1), b3 + hstep, voffB);
            PG8_WAIT_V(6); PG8_BAR; PG8_MMA(1, 1, At, B1); PG8_BAR;
            }
        }
        if constexpr (ALIGN_EPI) { if (wr == 0) PG8_BAR; }
        if constexpr (!Epi::AFTER_DRAIN) { E(acc, cur, wr, wc, fr, fq); S.done(cur); }
        if (!has_next) break;
#pragma unroll
        for (int a = 0; a < 2; ++a)
#pragma unroll
            for (int b = 0; b < 2; ++b)
#pragma unroll
                for (int m = 0; m < 4; ++m)
#pragma unroll
                    for (int n = 0; n < 2; ++n) acc[a][b][m][n] = (f32x4){0.f, 0.f, 0.f, 0.f};
        cur = nxt; cA = nA; cB = nB; ++ui;
        if constexpr (ALIGN_EPI) { if (wr == 1) PG8_BAR; }
    }
    PG8_WAIT_V(0);
    if constexpr (!ALIGN_EPI) { if (wr == 0) PG8_BAR; }
    PG8_BAR;
    if constexpr (Epi::AFTER_DRAIN) { E.fused(acc, cur, wr, wc, fr, fq, lds, wid, lane); S.done(cur); }
#undef PG8_SA
#undef PG8_SB
#undef PG8_STAGE
#undef PG8_LDA
#undef PG8_LDB
#undef PG8_MMA
#undef PG8_WAIT_V
#undef PG8_WAIT_L
#undef PG8_BAR
#undef PG8_SCHED
}
}

#ifndef MK_N_LAUNCHES
#define MK_N_LAUNCHES 1
#endif
#define LAS __attribute__((address_space(3)))
typedef unsigned short bf16;
typedef unsigned v4u __attribute__((ext_vector_type(4)));
typedef unsigned v2u __attribute__((ext_vector_type(2)));
typedef float f32x4 __attribute__((ext_vector_type(4)));
typedef short bf16x8 __attribute__((ext_vector_type(8)));
typedef short s16x4 __attribute__((ext_vector_type(4)));

constexpr int D = 1024, M = 16384, MP = 8192, NPROJ = 3104, NPP = 3328, FF = 4096;
constexpr int C_QA = 0, C_KA = 512, C_VA = 1024, C_QB = 1536, C_KB = 1792, C_VB = 2048, C_RB = 2560, C_GL = 3072;
constexpr float EPS = 1e-6f;
constexpr int NWAVES = 8, NTHR = 512;
constexpr int LDS_BYTES = 147456;

constexpr size_t MiB = 1u << 20;
constexpr size_t WS_WIN = 2 * MiB, WS_WOUT = 9 * MiB, WS_W1 = 11 * MiB, WS_W2 = 19 * MiB;
constexpr size_t WS_MOD = 27 * MiB, WS_ROPE = 27 * MiB + 512 * 1024, WS_CK = 28 * MiB, WS_CV = 30 * MiB;
constexpr size_t WS_XN = 32 * MiB, WS_PROJ = 64 * MiB, WS_GATE = 168 * MiB, WS_A2 = 170 * MiB, WS_OGF = 202 * MiB, WS_OGB = 218 * MiB;
constexpr size_t WS_MIX = 64 * MiB, WS_H = 64 * MiB, WS_F = 192 * MiB;
constexpr size_t O_Y = 0, O_NK = 16777216, O_NV = 20971520, O_SF = 25165824, O_SB = 26214400;

struct Params {
    const float *xp, *xs, *c, *cache_k, *cache_v, *state_f, *state_b, *c_ctx, *w_ada, *b_ada;
    const float *g_attn_pre, *g_attn_post, *g_mlp_pre, *g_mlp_post, *w_in, *wg_f, *bg_f, *wg_b, *bg_b;
    const float *lq1, *lk1, *lq2, *lk2, *diff_norm, *gla_norm, *w_out, *w_mlp1, *w_mlp2;
    float* out; unsigned char* ws;
    int ph_lo, ph_hi;
};

__device__ __forceinline__ unsigned f2bf(float f) { unsigned u = __builtin_bit_cast(unsigned, f); return (u + 0x7fffu + ((u >> 16) & 1u)) >> 16; }
__device__ __forceinline__ unsigned pk2(float lo, float hi) { return f2bf(lo) | (f2bf(hi) << 16); }
__device__ __forceinline__ float bf2f(unsigned short b) { return __builtin_bit_cast(float, (unsigned)b << 16); }
__device__ __forceinline__ float bflo(unsigned w) { return __builtin_bit_cast(float, w << 16); }
__device__ __forceinline__ float bfhi(unsigned w) { return __builtin_bit_cast(float, w & 0xffff0000u); }
__device__ __forceinline__ float wave_sum(float v) {
#pragma unroll
    for (int o = 1; o < 64; o <<= 1) v += __shfl_xor(v, o);
    return v;
}
__device__ __forceinline__ s16x4 trrd(const LAS unsigned char* p) { return __builtin_bit_cast(s16x4, __builtin_amdgcn_ds_read_tr16_b64_v4i16((LAS s16x4*)p)); }
__device__ __forceinline__ bf16x8 cat4(s16x4 lo, s16x4 hi) { return (bf16x8){lo[0], lo[1], lo[2], lo[3], hi[0], hi[1], hi[2], hi[3]}; }
__device__ __forceinline__ bf16x8 pack8(f32x4 a, f32x4 b) { v4u w; w.x = pk2(a[0], a[1]); w.y = pk2(a[2], a[3]); w.z = pk2(b[0], b[1]); w.w = pk2(b[2], b[3]); return __builtin_bit_cast(bf16x8, w); }
#define MFMA16(a, b, c) __builtin_amdgcn_mfma_f32_16x16x32_bf16((a), (b), (c), 0, 0, 0)

namespace pg8 {
struct EpiF32 {
    static constexpr bool PERM = true, AFTER_DRAIN = false;
    float* O; int ldc;
    __device__ __forceinline__ void operator()(const f32x4 (&acc)[2][2][4][2], const Unit& u, int wr, int wc, int fr, int fq) const {
#pragma unroll
        for (int ai = 0; ai < 2; ++ai)
#pragma unroll
            for (int m = 0; m < 4; ++m) { float* rp = O + (size_t)(u.pm * BM + ai * HALF + wr * 64 + m * 16 + fr) * ldc + u.pn * BM + wc * 32 + 8 * fq;
#pragma unroll
                for (int bj = 0; bj < 2; ++bj) { *(f32x4*)(rp + bj * HALF) = acc[ai][bj][m][0]; *(f32x4*)(rp + bj * HALF + 4) = acc[ai][bj][m][1]; } }
    }
};
struct EpiRelu2 {
    static constexpr bool PERM = true, AFTER_DRAIN = false;
    bf16_t* O; int ldc;
    __device__ __forceinline__ void operator()(const f32x4 (&acc)[2][2][4][2], const Unit& u, int wr, int wc, int fr, int fq) const {
#pragma unroll
        for (int ai = 0; ai < 2; ++ai)
#pragma unroll
            for (int m = 0; m < 4; ++m) { bf16_t* rp = O + (size_t)(u.pm * BM + ai * HALF + wr * 64 + m * 16 + fr) * ldc + u.pn * BM + wc * 32 + 8 * fq;
#pragma unroll
                for (int bj = 0; bj < 2; ++bj) { f32x4 a = acc[ai][bj][m][0], b = acc[ai][bj][m][1];
#pragma unroll
                    for (int j = 0; j < 4; ++j) { a[j] = a[j] > 0.f ? a[j] * a[j] : 0.f; b[j] = b[j] > 0.f ? b[j] * b[j] : 0.f; }
                    u32x4 w; w.x = cvt_pk_bf16(a[0], a[1]); w.y = cvt_pk_bf16(a[2], a[3]); w.z = cvt_pk_bf16(b[0], b[1]); w.w = cvt_pk_bf16(b[2], b[3]);
                    *(u32x4*)(rp + bj * HALF) = w; } }
    }
};
struct EpiInProj {
    static constexpr bool PERM = false, AFTER_DRAIN = false;
    bf16_t* P; float* GATE; float* newk; float* newv; const float* COS; const float* SIN;
    __device__ __forceinline__ void operator()(const f32x4 (&acc)[2][2][4][2], const Unit& u, int wr, int wc, int fr, int fq) const {
        typedef unsigned u32x2 __attribute__((ext_vector_type(2)));
        const int pn = u.pn;
#pragma unroll
        for (int ai = 0; ai < 2; ++ai)
#pragma unroll
            for (int m = 0; m < 4; ++m) {
                const int row = u.pm * BM + ai * HALF + wr * 64 + m * 16 + fr;
                const bool samp = row >= 8192;
                const int t = (row - 8192) & 1023;
#pragma unroll
                for (int bj = 0; bj < 2; ++bj) {
                    const int col0 = pn * BM + bj * HALF + wc * 32 + 4 * fq;
                    f32x4 v0 = acc[ai][bj][m][0], v1 = acc[ai][bj][m][1];
                    if (pn < 4 && samp) {
                        const int pos = ((col0 >> 5) & 1) ? (t & 63) : (t >> 6);
                        const f32x4 cs = *(const f32x4*)(COS + pos * 16 + 4 * fq), sn = *(const f32x4*)(SIN + pos * 16 + 4 * fq);
                        const f32x4 o0 = v0 * cs - v1 * sn, o1 = v0 * sn + v1 * cs; v0 = o0; v1 = o1;
                    }
                    if (pn == 12) {
                        if (bj == 0 && wc == 0) { *(f32x4*)(GATE + (size_t)row * 32 + 4 * fq) = v0; *(f32x4*)(GATE + (size_t)row * 32 + 16 + 4 * fq) = v1; }
                    } else {
                        bf16_t* pp = P + (size_t)row * 3328 + col0;
                        u32x2 w0, w1; w0.x = cvt_pk_bf16(v0[0], v0[1]); w0.y = cvt_pk_bf16(v0[2], v0[3]); w1.x = cvt_pk_bf16(v1[0], v1[1]); w1.y = cvt_pk_bf16(v1[2], v1[3]);
                        *(u32x2*)pp = w0; *(u32x2*)(pp + 16) = w1;
                        if (!samp && pn >= 2 && pn < 6) {
                            const int cc = (col0 - 512) & 511, hh = cc >> 7, dd = cc & 127;
                            float* op = (pn < 4 ? newk : newv) + ((size_t)((row >> 8) * 4 + hh) * 256 + (row & 255)) * 128 + dd;
                            *(f32x4*)op = v0; *(f32x4*)(op + 16) = v1;
                        }
                    }
                }
            }
    }
};
}

__device__ __forceinline__ void p0_transpose_item(const float* __restrict__ W, int K, int N, bf16* WT, LAS float* scr, int item, int lane) {
    const int nblk = N / 32, kb = item / nblk, nb = item % nblk, k0 = 64 * kb, n0 = 32 * nb;
#pragma unroll 8
    for (int i = 0; i < 32; ++i) { const int kk = 2 * i + (lane >> 5); scr[kk * 33 + (lane & 31)] = W[(size_t)(k0 + kk) * N + n0 + (lane & 31)]; }
    asm volatile("s_waitcnt lgkmcnt(0)" ::: "memory");
    const int c = lane & 7;
#pragma unroll
    for (int j = 0; j < 4; ++j) { const int n = (lane >> 3) + 8 * j; const LAS float* s = scr + (8 * c) * 33 + n;
        v4u o; o.x = pk2(s[0 * 33], s[1 * 33]); o.y = pk2(s[2 * 33], s[3 * 33]); o.z = pk2(s[4 * 33], s[5 * 33]); o.w = pk2(s[6 * 33], s[7 * 33]);
        *(v4u*)(WT + (size_t)(n0 + n) * K + k0 + 8 * c) = o; }
    asm volatile("s_waitcnt lgkmcnt(0)" ::: "memory");
}
__device__ __forceinline__ void sincos_tab(float ang, float& s, float& c) {
    const double x = (double)ang; const double k = rint(x * 0.15915494309189535);
    double r = fma(-k, 6.283185307179586, x); r = fma(-k, 2.4492935982947064e-16, r);
    const double r2 = r * r; double ts = 1.0, tc = 1.0, ss = 1.0, cc = 1.0;
#pragma unroll
    for (int n = 1; n <= 13; ++n) { tc *= -r2 * (1.0 / (double)((2 * n - 1) * (2 * n))); cc += tc; ts *= -r2 * (1.0 / (double)((2 * n) * (2 * n + 1))); ss += ts; }
    s = (float)(r * ss); c = (float)cc;
}
__device__ __forceinline__ void phase0(const Params& p, LAS unsigned char* lds) {
    const int tid = threadIdx.x, lane = tid & 63, wave = __builtin_amdgcn_readfirstlane(tid >> 6);
    unsigned char* ws = p.ws;
    float* MOD = (float*)(ws + WS_MOD);
    {
        LAS float* Ssil = (LAS float*)lds; LAS float* part = (LAS float*)(lds + 36864);
        bool have = false;
        for (int j = blockIdx.x; j < 96; j += gridDim.x) {
            if (!have) {
                for (int i = tid; i < 9 * 1024; i += NTHR) { const int r = i >> 10, k = i & 1023; const float v = (r == 0) ? p.c_ctx[k] : p.c[(r - 1) * 1024 + k]; Ssil[i] = v / (1.f + __expf(-v)); }
                __syncthreads(); have = true;
            }
            float a0 = 0.f, a1 = 0.f, a2 = 0.f, a3 = 0.f, a4 = 0.f, a5 = 0.f, a6 = 0.f, a7 = 0.f, a8 = 0.f;
            const int col = 64 * j + lane, k0 = wave * 128;
            const float* wp = p.w_ada + (size_t)k0 * 6144 + col;
#pragma unroll 8
            for (int kk = 0; kk < 128; ++kk) {
                const float w = wp[(size_t)kk * 6144]; const LAS float* sp = Ssil + k0 + kk;
                a0 += sp[0] * w; a1 += sp[1024] * w; a2 += sp[2048] * w; a3 += sp[3072] * w; a4 += sp[4096] * w; a5 += sp[5120] * w; a6 += sp[6144] * w; a7 += sp[7168] * w; a8 += sp[8192] * w;
            }
            LAS float* pp = part + wave * 576 + lane;
            pp[0] = a0; pp[64] = a1; pp[128] = a2; pp[192] = a3; pp[256] = a4; pp[320] = a5; pp[384] = a6; pp[448] = a7; pp[512] = a8;
            __syncthreads();
            for (int i = tid; i < 576; i += NTHR) { const int r = i >> 6, ci = i & 63; float s = p.b_ada[64 * j + ci];
#pragma unroll
                for (int w = 0; w < 8; ++w) s += part[w * 576 + i];
                MOD[r * 6144 + 64 * j + ci] = s; }
            __syncthreads();
        }
        __syncthreads();
    }
    if (blockIdx.x == gridDim.x - 1) {
        float* COS = (float*)(ws + WS_ROPE); float* SIN = COS + 1024;
        for (int i = tid; i < 1024; i += NTHR) { const int pos = i >> 4, fi = i & 15; const float inv = exp2f(-(float)fi * (13.287712379549449f / 16.f));
            float s, c; sincos_tab((float)pos * inv, s, c); COS[i] = c; SIN[i] = s; }
    }
    {
        LAS float* scr = (LAS float*)(lds + wave * 16384);
        const int gw = blockIdx.x * NWAVES + wave, NGW = gridDim.x * NWAVES;
        constexpr int I_IN = 16 * 97, I_O = 16 * 32, I_1 = 16 * 128, I_2 = 64 * 32, NIT = I_IN + I_O + I_1 + I_2;
        for (int it = gw; it < NIT; it += NGW) {
            int r = it;
            if (r < I_IN) { p0_transpose_item(p.w_in, 1024, NPROJ, (bf16*)(ws + WS_WIN), scr, r, lane); continue; } r -= I_IN;
            if (r < I_O) { p0_transpose_item(p.w_out, 1024, 1024, (bf16*)(ws + WS_WOUT), scr, r, lane); continue; } r -= I_O;
            if (r < I_1) { p0_transpose_item(p.w_mlp1, 1024, 4096, (bf16*)(ws + WS_W1), scr, r, lane); continue; } r -= I_1;
            p0_transpose_item(p.w_mlp2, 4096, 1024, (bf16*)(ws + WS_W2), scr, r, lane);
        }
    }
    {
        const int gt = blockIdx.x * NTHR + tid, NGT = gridDim.x * NTHR;
        v4u* zp = (v4u*)(ws + WS_WIN + (size_t)NPROJ * 1024 * 2);
        for (int i = gt; i < (NPP - NPROJ) * 1024 * 2 / 16; i += NGT) zp[i] = (v4u){0u, 0u, 0u, 0u};
        const f32x4* ck = (const f32x4*)p.cache_k; const f32x4* cv = (const f32x4*)p.cache_v;
        v2u* ok = (v2u*)(ws + WS_CK); v2u* ov = (v2u*)(ws + WS_CV);
        for (int i = gt; i < 262144; i += NGT) { const f32x4 a = ck[i], b = cv[i]; v2u x, y; x.x = pk2(a[0], a[1]); x.y = pk2(a[2], a[3]); y.x = pk2(b[0], b[1]); y.y = pk2(b[2], b[3]); ok[i] = x; ov[i] = y; }
    }
}

__device__ __forceinline__ void phase1(const Params& p) {
    const int tid = threadIdx.x, lane = tid & 63, wave = tid >> 6;
    const float* MOD = (const float*)(p.ws + WS_MOD); bf16* XN = (bf16*)(p.ws + WS_XN);
    const int gw = blockIdx.x * NWAVES + wave, NGW = gridDim.x * NWAVES;
    for (int row = gw; row < M; row += NGW) {
        const float* xr = row < MP ? p.xp + (size_t)row * D : p.xs + (size_t)(row - MP) * D;
        const int r = row < MP ? 0 : 1 + ((row - MP) >> 10);
        f32x4 v[4]; float s2 = 0.f;
#pragma unroll
        for (int j = 0; j < 4; ++j) { v[j] = ((const f32x4*)xr)[lane + 64 * j]; s2 += (v[j][0] * v[j][0] + v[j][1] * v[j][1]) + (v[j][2] * v[j][2] + v[j][3] * v[j][3]); }
        const float rstd = 1.0f / sqrtf(wave_sum(s2) * (1.f / D) + EPS);
        const float* mr = MOD + r * 6144;
#pragma unroll
        for (int j = 0; j < 4; ++j) { const int q = lane + 64 * j;
            const f32x4 g = ((const f32x4*)p.g_attn_pre)[q], sh = ((const f32x4*)mr)[q], sc = ((const f32x4*)(mr + 1024))[q];
            const f32x4 h = (v[j] * rstd * g) * (sc + 1.0f) + sh;
            v2u w; w.x = pk2(h[0], h[1]); w.y = pk2(h[2], h[3]); ((v2u*)(XN + (size_t)row * D))[q] = w; }
    }
}

constexpr int KP = 272, VP = 288, KT_BYTES = 64 * KP, VT_BYTES = 64 * VP, ABUF = KT_BYTES + VT_BYTES;
constexpr float CS = 0.125f * 1.4426950408889634f;

__device__ __forceinline__ void att_load(const Params& p, int samp, int b, int h, int t, int tid, v4u (&kr)[2], v4u (&vr)[2]) {
    const bf16* PROJ = (const bf16*)(p.ws + WS_PROJ);
#pragma unroll
    for (int i = 0; i < 2; ++i) {
        const int id = tid + 512 * i, r = id >> 4, ch = id & 15;
        const bf16 *kp, *vp;
        if (samp && t < 4) { const size_t o = ((size_t)(b * 4 + h) * 256 + t * 64 + r) * 128 + ch * 8; kp = (const bf16*)(p.ws + WS_CK) + o; vp = (const bf16*)(p.ws + WS_CV) + o; }
        else { const int row = samp ? (MP + b * 1024 + (t - 4) * 64 + r) : (b * 256 + t * 64 + r); const bf16* rp = PROJ + (size_t)row * NPP + h * 128 + ch * 8; kp = rp + C_KA; vp = rp + C_VA; }
        kr[i] = *(const v4u*)kp; vr[i] = *(const v4u*)vp;
    }
}
__device__ __forceinline__ void att_store(LAS unsigned char* buf, int tid, const v4u (&kr)[2], const v4u (&vr)[2]) {
#pragma unroll
    for (int i = 0; i < 2; ++i) { const int id = tid + 512 * i, r = id >> 4, ch = id & 15;
        *(LAS v4u*)(buf + r * KP + ch * 16) = kr[i]; *(LAS v4u*)(buf + KT_BYTES + r * VP + ch * 16) = vr[i]; }
}
__device__ __forceinline__ void softmax_step(f32x4 (&S)[4], float& m, float& l, f32x4 (&O)[8]) {
    float mx = S[0][0];
#pragma unroll
    for (int kb = 0; kb < 4; ++kb)
#pragma unroll
        for (int r = 0; r < 4; ++r) mx = fmaxf(mx, S[kb][r]);
    mx = fmaxf(mx, __shfl_xor(mx, 16)); mx = fmaxf(mx, __shfl_xor(mx, 32));
    const float mnew = fmaxf(m, mx * CS), alpha = __builtin_amdgcn_exp2f(m - mnew); m = mnew;
    float ps = 0.f;
#pragma unroll
    for (int kb = 0; kb < 4; ++kb)
#pragma unroll
        for (int r = 0; r < 4; ++r) { const float pv = __builtin_amdgcn_exp2f(S[kb][r] * CS - mnew); S[kb][r] = pv; ps += pv; }
    l = l * alpha + ps;
#pragma unroll
    for (int c = 0; c < 8; ++c) O[c] = O[c] * alpha;
}
__device__ __forceinline__ void attn_unit(const Params& p, LAS unsigned char* lds, int samp, int b, int h, int qb, float lam) {
    const int tid = threadIdx.x, lane = tid & 63, wave = __builtin_amdgcn_readfirstlane(tid >> 6), g = lane >> 4, fr = lane & 15;
    const bf16* PROJ = (const bf16*)(p.ws + WS_PROJ);
    const int rowbase = samp ? MP + b * 1024 : b * 256, NT = samp ? 20 : 4;
    const int qrow = rowbase + qb * 128 + wave * 16 + fr;
    bf16x8 Qf[4];
#pragma unroll
    for (int ds = 0; ds < 4; ++ds) Qf[ds] = *(const bf16x8*)(PROJ + (size_t)qrow * NPP + C_QA + h * 128 + 32 * ds + 8 * g);
    f32x4 O1[8], O2[8];
#pragma unroll
    for (int c = 0; c < 8; ++c) { O1[c] = (f32x4){0.f, 0.f, 0.f, 0.f}; O2[c] = (f32x4){0.f, 0.f, 0.f, 0.f}; }
    float m1 = -INFINITY, m2 = -INFINITY, l1 = 0.f, l2 = 0.f;
    v4u kr[2], vr[2];
    att_load(p, samp, b, h, 0, tid, kr, vr);
    att_store(lds, tid, kr, vr);
    __syncthreads();
    for (int t = 0; t < NT; ++t) {
        const LAS unsigned char* Kb = lds + (t & 1) * ABUF; const LAS unsigned char* Vb = Kb + KT_BYTES;
        if (t + 1 < NT) att_load(p, samp, b, h, t + 1, tid, kr, vr);
        f32x4 S1[4], S2[4];
#pragma unroll
        for (int kb = 0; kb < 4; ++kb) {
            const LAS unsigned char* kp = Kb + (16 * kb + fr) * KP + 16 * g;
            const bf16x8 k0 = *(const LAS bf16x8*)kp, k1 = *(const LAS bf16x8*)(kp + 64), k2 = *(const LAS bf16x8*)(kp + 128), k3 = *(const LAS bf16x8*)(kp + 192);
            f32x4 z = (f32x4){0.f, 0.f, 0.f, 0.f};
            S1[kb] = MFMA16(k0, Qf[0], z); S1[kb] = MFMA16(k1, Qf[1], S1[kb]);
            S2[kb] = MFMA16(k2, Qf[2], z); S2[kb] = MFMA16(k3, Qf[3], S2[kb]);
        }
        softmax_step(S1, m1, l1, O1);
        softmax_step(S2, m2, l2, O2);
        bf16x8 P1[2], P2[2];
#pragma unroll
        for (int kk = 0; kk < 2; ++kk) { P1[kk] = pack8(S1[2 * kk], S1[2 * kk + 1]); P2[kk] = pack8(S2[2 * kk], S2[2 * kk + 1]); }
        const LAS unsigned char* vb = Vb + (4 * g + (fr >> 2)) * VP + 8 * (fr & 3);
#pragma unroll
        for (int kk = 0; kk < 2; ++kk)
#pragma unroll
            for (int c = 0; c < 8; ++c) {
                const s16x4 lo = trrd(vb + kk * 32 * VP + c * 32), hi = trrd(vb + kk * 32 * VP + 16 * VP + c * 32);
                const bf16x8 vf = cat4(lo, hi);
                O1[c] = MFMA16(vf, P1[kk], O1[c]); O2[c] = MFMA16(vf, P2[kk], O2[c]);
            }
        if (t + 1 < NT) att_store(lds + ((t + 1) & 1) * ABUF, tid, kr, vr);
        __syncthreads();
    }
    l1 += __shfl_xor(l1, 16); l1 += __shfl_xor(l1, 32); l2 += __shfl_xor(l2, 16); l2 += __shfl_xor(l2, 32);
    const float i1 = 1.0f / l1, i2 = lam / l2; float ss = 0.f;
#pragma unroll
    for (int c = 0; c < 8; ++c) { O1[c] = O1[c] * i1 - O2[c] * i2; ss += (O1[c][0] * O1[c][0] + O1[c][1] * O1[c][1]) + (O1[c][2] * O1[c][2] + O1[c][3] * O1[c][3]); }
    ss += __shfl_xor(ss, 16); ss += __shfl_xor(ss, 32);
    const float rstd = (1.0f / sqrtf(ss * (1.f / 128.f) + EPS)) * 0.8f;
    bf16* A2 = (bf16*)(p.ws + WS_A2) + (size_t)qrow * D + h * 128 + 4 * g;
#pragma unroll
    for (int c = 0; c < 8; ++c) { const f32x4 dn = *(const f32x4*)(p.diff_norm + 16 * c + 4 * g); const f32x4 o = O1[c] * rstd * dn;
        v2u w; w.x = pk2(o[0], o[1]); w.y = pk2(o[2], o[3]); *(v2u*)(A2 + 16 * c) = w; }
}

constexpr int QP = 144, HP = 160;
constexpr int G_QT = 0, G_KT = 64 * QP, G_KH = 2 * 64 * QP, G_VT = G_KH + 64 * HP, G_BL = G_VT + 64 * HP, G_WG = G_BL + 256, G_BG = G_WG + 4096, G_END = G_BG + 256;
__device__ __forceinline__ float logsig(float x) { return fminf(x, 0.f) - __logf(1.f + __expf(-fabsf(x))); }

__device__ __forceinline__ void gla_unit(const Params& p, LAS unsigned char* lds, int samp, int b, int h, int dir, int dvh) {
    const int tid = threadIdx.x, lane = tid & 63, wave = __builtin_amdgcn_readfirstlane(tid >> 6), g = lane >> 4, fr = lane & 15;
    const bf16* PROJ = (const bf16*)(p.ws + WS_PROJ); const float* GATE = (const float*)(p.ws + WS_GATE);
    bf16* OG = (bf16*)(p.ws + (dir ? WS_OGB : WS_OGF));
    const int L = samp ? 1024 : 256, NC = L / 64, rowbase = samp ? MP + b * 1024 : b * 256;
    const int c = wave & 3, ah = wave >> 2;
    LAS float* WgL = (LAS float*)(lds + G_WG); LAS float* BgL = (LAS float*)(lds + G_BG); LAS float* BL = (LAS float*)(lds + G_BL);
    {
        const float* wg = dir ? p.wg_b : p.wg_f; const float* bg = dir ? p.bg_b : p.bg_f;
        for (int i = tid; i < 1024; i += NTHR) WgL[i] = wg[(i >> 6) * 256 + h * 64 + (i & 63)];
        if (tid < 64) BgL[tid] = bg[h * 64 + tid];
    }
    f32x4 S[4];
    if (samp) { const float* st = (dir ? p.state_b : p.state_f) + (size_t)(b * 4 + h) * 64 * 128 + dvh * 64 + 16 * c + fr;
#pragma unroll
        for (int kb = 0; kb < 4; ++kb)
#pragma unroll
            for (int r = 0; r < 4; ++r) S[kb][r] = st[(16 * kb + 4 * g + r) * 128]; }
    else {
#pragma unroll
        for (int kb = 0; kb < 4; ++kb) S[kb] = (f32x4){0.f, 0.f, 0.f, 0.f}; }
    __syncthreads();
    for (int ch = 0; ch < NC; ++ch) {
        {
            const int tpos = ch * 64 + lane, tok = dir ? (L - 1 - tpos) : tpos, row = rowbase + tok;
            const float* gp = GATE + (size_t)row * 32 + dir * 16;
            const f32x4 g0 = *(const f32x4*)gp, g1 = *(const f32x4*)(gp + 4), g2 = *(const f32x4*)(gp + 8), g3 = *(const f32x4*)(gp + 12);
            const bf16* rp = PROJ + (size_t)row * NPP;
            const v4u qw = *(const v4u*)(rp + C_QB + h * 64 + 8 * wave), kw = *(const v4u*)(rp + C_KB + h * 64 + 8 * wave);
            const v4u vw = *(const v4u*)(rp + C_VB + h * 128 + dvh * 64 + 8 * wave);
            float gl[16] = {g0[0], g0[1], g0[2], g0[3], g1[0], g1[1], g1[2], g1[3], g2[0], g2[1], g2[2], g2[3], g3[0], g3[1], g3[2], g3[3]};
            float x[8];
#pragma unroll
            for (int e = 0; e < 8; ++e) x[e] = BgL[8 * wave + e];
#pragma unroll
            for (int j = 0; j < 16; ++j) { const f32x4 wa = *(const LAS f32x4*)(WgL + j * 64 + 8 * wave), wb = *(const LAS f32x4*)(WgL + j * 64 + 8 * wave + 4);
#pragma unroll
                for (int e = 0; e < 4; ++e) { x[e] += gl[j] * wa[e]; x[4 + e] += gl[j] * wb[e]; } }
            float qf[8], kf[8];
#pragma unroll
            for (int e = 0; e < 4; ++e) { const unsigned a = qw[e], bb = kw[e]; qf[2 * e] = bflo(a); qf[2 * e + 1] = bfhi(a); kf[2 * e] = bflo(bb); kf[2 * e + 1] = bfhi(bb); }
            float qt[8], kt[8], kh[8];
#pragma unroll
            for (int e = 0; e < 8; ++e) {
                float v = logsig(x[e]) * (1.f / 16.f);
#pragma unroll
                for (int o = 1; o < 64; o <<= 1) { const float u = __shfl_up(v, o); if (lane >= o) v += u; }
                const float blast = __shfl(v, 63);
                qt[e] = qf[e] * 0.125f * __expf(v); kt[e] = kf[e] * __expf(-v); kh[e] = kf[e] * __expf(blast - v);
                if (lane == 63) BL[8 * wave + e] = __expf(blast);
            }
            v4u w;
            w.x = pk2(qt[0], qt[1]); w.y = pk2(qt[2], qt[3]); w.z = pk2(qt[4], qt[5]); w.w = pk2(qt[6], qt[7]); *(LAS v4u*)(lds + G_QT + lane * QP + 16 * wave) = w;
            w.x = pk2(kt[0], kt[1]); w.y = pk2(kt[2], kt[3]); w.z = pk2(kt[4], kt[5]); w.w = pk2(kt[6], kt[7]); *(LAS v4u*)(lds + G_KT + lane * QP + 16 * wave) = w;
            w.x = pk2(kh[0], kh[1]); w.y = pk2(kh[2], kh[3]); w.z = pk2(kh[4], kh[5]); w.w = pk2(kh[6], kh[7]); *(LAS v4u*)(lds + G_KH + lane * HP + 16 * wave) = w;
            *(LAS v4u*)(lds + G_VT + lane * HP + 16 * wave) = vw;
        }
        __syncthreads();
        const LAS unsigned char* vtb = lds + G_VT + 32 * c + 8 * (fr & 3);
#pragma unroll
        for (int ai = 0; ai < 2; ++ai) {
            const int a = 2 * ah + ai;
            f32x4 at[4];
#pragma unroll
            for (int sb = 0; sb < 4; ++sb) {
                at[sb] = (f32x4){0.f, 0.f, 0.f, 0.f};
                if (sb <= a) {
#pragma unroll
                    for (int ks = 0; ks < 2; ++ks) { const bf16x8 kfr = *(const LAS bf16x8*)(lds + G_KT + (16 * sb + fr) * QP + 64 * ks + 16 * g);
                        const bf16x8 qfr = *(const LAS bf16x8*)(lds + G_QT + (16 * a + fr) * QP + 64 * ks + 16 * g);
                        at[sb] = MFMA16(kfr, qfr, at[sb]); }
                    if (sb == a) {
#pragma unroll
                        for (int r = 0; r < 4; ++r) if (4 * g + r > fr) at[sb][r] = 0.f; }
                }
            }
            f32x4 o = (f32x4){0.f, 0.f, 0.f, 0.f};
#pragma unroll
            for (int ks = 0; ks < 2; ++ks) {
                const LAS unsigned char* qp = lds + G_QT + (16 * a + fr) * QP + (32 * ks + 4 * g) * 2;
                const v2u lo = *(const LAS v2u*)qp, hi = *(const LAS v2u*)(qp + 32);
                const v4u aw = (v4u){lo.x, lo.y, hi.x, hi.y};
                o = MFMA16(__builtin_bit_cast(bf16x8, aw), pack8(S[2 * ks], S[2 * ks + 1]), o);
            }
#pragma unroll
            for (int ss = 0; ss < 2; ++ss) {
                if (2 * ss <= a) {
                    const s16x4 lo = trrd(vtb + (32 * ss + 4 * g + (fr >> 2)) * HP), hi = trrd(vtb + (32 * ss + 16 + 4 * g + (fr >> 2)) * HP);
                    o = MFMA16(pack8(at[2 * ss], at[2 * ss + 1]), cat4(lo, hi), o);
                }
            }
#pragma unroll
            for (int r = 0; r < 4; ++r) { const int tpos = ch * 64 + 16 * a + 4 * g + r, tok = dir ? (L - 1 - tpos) : tpos;
                OG[(size_t)(rowbase + tok) * 512 + h * 128 + dvh * 64 + 16 * c + fr] = (bf16)f2bf(o[r]); }
        }
        {
            bf16x8 vfr[2];
#pragma unroll
            for (int ts = 0; ts < 2; ++ts) { const s16x4 lo = trrd(vtb + (32 * ts + 8 * g + (fr >> 2)) * HP), hi = trrd(vtb + (32 * ts + 8 * g + 4 + (fr >> 2)) * HP); vfr[ts] = cat4(lo, hi); }
#pragma unroll
            for (int kb = 0; kb < 4; ++kb) {
                const f32x4 dc = *(const LAS f32x4*)(BL + 16 * kb + 4 * g);
                S[kb] = S[kb] * dc;
#pragma unroll
                for (int ts = 0; ts < 2; ++ts) {
                    const LAS unsigned char* kp = lds + G_KH + (32 * ts + 8 * g + (fr >> 2)) * HP + 32 * kb + 8 * (fr & 3);
                    const s16x4 lo = trrd(kp), hi = trrd(kp + 4 * HP);
                    S[kb] = MFMA16(cat4(lo, hi), vfr[ts], S[kb]);
                }
            }
        }
        __syncthreads();
    }
    if (!samp && ah == 0) {
        float* so = p.out + (dir ? O_SB : O_SF) + (size_t)(b * 4 + h) * 64 * 128 + dvh * 64 + 16 * c + fr;
#pragma unroll
        for (int kb = 0; kb < 4; ++kb)
#pragma unroll
            for (int r = 0; r < 4; ++r) so[(16 * kb + 4 * g + r) * 128] = S[kb][r];
    }
}

__device__ __forceinline__ void phase3(const Params& p, LAS unsigned char* lds) {
    const int lane = threadIdx.x & 63;
    float lam;
    { const float a = wave_sum(p.lq1[lane] * p.lk1[lane]), b = wave_sum(p.lq2[lane] * p.lk2[lane]); lam = __expf(a) - __expf(b) + 0.2f; }
    for (int u = blockIdx.x; u < 256; u += gridDim.x) attn_unit(p, lds, 0, u >> 3, (u >> 1) & 3, u & 1, lam);
    for (int u = blockIdx.x; u < 256; u += gridDim.x) attn_unit(p, lds, 1, u >> 5, (u >> 3) & 3, u & 7, lam);
    __syncthreads();
    for (int u = blockIdx.x; u < 256; u += gridDim.x) {
        if (u < 128) gla_unit(p, lds, 1, u >> 4, (u >> 2) & 3, (u >> 1) & 1, u & 1);
        else { for (int i = 0; i < 4; ++i) { const int pu = (u - 128) * 4 + i; gla_unit(p, lds, 0, pu >> 4, (pu >> 2) & 3, (pu >> 1) & 1, pu & 1); } }
    }
}

__device__ __forceinline__ void phase3b(const Params& p) {
    const int tid = threadIdx.x, lane = tid & 63, wave = tid >> 6;
    const bf16* PROJ = (const bf16*)(p.ws + WS_PROJ); const bf16* OGF = (const bf16*)(p.ws + WS_OGF); const bf16* OGB = (const bf16*)(p.ws + WS_OGB);
    bf16* A2 = (bf16*)(p.ws + WS_A2);
    const int gw = blockIdx.x * NWAVES + wave, NGW = gridDim.x * NWAVES;
    const f32x4 n0 = *(const f32x4*)(p.gla_norm + 8 * (lane & 15)), n1 = *(const f32x4*)(p.gla_norm + 8 * (lane & 15) + 4);
    for (int row = gw; row < M; row += NGW) {
        const v4u a = *(const v4u*)(OGF + (size_t)row * 512 + 8 * lane), bq = *(const v4u*)(OGB + (size_t)row * 512 + 8 * lane);
        const v4u rw = *(const v4u*)(PROJ + (size_t)row * NPP + C_RB + 8 * lane);
        float o[8], rr[8]; float ss = 0.f;
#pragma unroll
        for (int e = 0; e < 4; ++e) { o[2 * e] = bflo(a[e]) + bflo(bq[e]); o[2 * e + 1] = bfhi(a[e]) + bfhi(bq[e]); rr[2 * e] = bflo(rw[e]); rr[2 * e + 1] = bfhi(rw[e]); }
#pragma unroll
        for (int e = 0; e < 8; ++e) ss += o[e] * o[e];
        ss += __shfl_xor(ss, 1); ss += __shfl_xor(ss, 2); ss += __shfl_xor(ss, 4); ss += __shfl_xor(ss, 8);
        const float rstd = 1.0f / sqrtf(ss * (1.f / 128.f) + EPS);
        float y[8];
#pragma unroll
        for (int e = 0; e < 8; ++e) { const float nw = e < 4 ? n0[e] : n1[e - 4]; const float sl = rr[e] / (1.f + __expf(-rr[e])); y[e] = o[e] * rstd * nw * sl; }
        v4u w; w.x = pk2(y[0], y[1]); w.y = pk2(y[2], y[3]); w.z = pk2(y[4], y[5]); w.w = pk2(y[6], y[7]);
        *(v4u*)(A2 + (size_t)row * D + 512 + 8 * lane) = w;
    }
}

__device__ __forceinline__ void phase5(const Params& p) {
    const int tid = threadIdx.x, lane = tid & 63, wave = tid >> 6;
    const float* MOD = (const float*)(p.ws + WS_MOD); bf16* XN = (bf16*)(p.ws + WS_XN); const float* MIX = (const float*)(p.ws + WS_MIX);
    const int gw = blockIdx.x * NWAVES + wave, NGW = gridDim.x * NWAVES;
    for (int row = gw; row < M; row += NGW) {
        const float* xr = row < MP ? p.xp + (size_t)row * D : p.xs + (size_t)(row - MP) * D;
        const int r = row < MP ? 0 : 1 + ((row - MP) >> 10);
        const float* mr = MOD + r * 6144;
        f32x4 v[4], mv[4]; float s2 = 0.f;
#pragma unroll
        for (int j = 0; j < 4; ++j) { mv[j] = ((const f32x4*)(MIX + (size_t)row * D))[lane + 64 * j]; v[j] = ((const f32x4*)xr)[lane + 64 * j]; s2 += (mv[j][0] * mv[j][0] + mv[j][1] * mv[j][1]) + (mv[j][2] * mv[j][2] + mv[j][3] * mv[j][3]); }
        const float rstd = 1.0f / sqrtf(wave_sum(s2) * (1.f / D) + EPS);
        float t2 = 0.f;
#pragma unroll
        for (int j = 0; j < 4; ++j) { const int q = lane + 64 * j;
            const f32x4 gp = ((const f32x4*)p.g_attn_post)[q], ga = ((const f32x4*)(mr + 2048))[q];
            v[j] = v[j] + ga * (mv[j] * rstd * gp);
            ((f32x4*)(p.out + O_Y + (size_t)row * D))[q] = v[j];
            t2 += (v[j][0] * v[j][0] + v[j][1] * v[j][1]) + (v[j][2] * v[j][2] + v[j][3] * v[j][3]); }
        const float rstd2 = 1.0f / sqrtf(wave_sum(t2) * (1.f / D) + EPS);
#pragma unroll
        for (int j = 0; j < 4; ++j) { const int q = lane + 64 * j;
            const f32x4 g = ((const f32x4*)p.g_mlp_pre)[q], sh = ((const f32x4*)(mr + 3072))[q], sc = ((const f32x4*)(mr + 4096))[q];
            const f32x4 h = (v[j] * rstd2 * g) * (sc + 1.0f) + sh;
            v2u w; w.x = pk2(h[0], h[1]); w.y = pk2(h[2], h[3]); ((v2u*)(XN + (size_t)row * D))[q] = w; }
    }
}
__device__ __forceinline__ void phase8(const Params& p) {
    const int tid = threadIdx.x, lane = tid & 63, wave = tid >> 6;
    const float* MOD = (const float*)(p.ws + WS_MOD); const float* F = (const float*)(p.ws + WS_F);
    const int gw = blockIdx.x * NWAVES + wave, NGW = gridDim.x * NWAVES;
    for (int row = gw; row < M; row += NGW) {
        const int r = row < MP ? 0 : 1 + ((row - MP) >> 10);
        const float* mr = MOD + r * 6144; float* yr = p.out + O_Y + (size_t)row * D;
        f32x4 v[4], fv[4]; float s2 = 0.f;
#pragma unroll
        for (int j = 0; j < 4; ++j) { fv[j] = ((const f32x4*)(F + (size_t)row * D))[lane + 64 * j]; v[j] = ((const f32x4*)yr)[lane + 64 * j]; s2 += (fv[j][0] * fv[j][0] + fv[j][1] * fv[j][1]) + (fv[j][2] * fv[j][2] + fv[j][3] * fv[j][3]); }
        const float rstd = 1.0f / sqrtf(wave_sum(s2) * (1.f / D) + EPS);
#pragma unroll
        for (int j = 0; j < 4; ++j) { const int q = lane + 64 * j;
            const f32x4 gp = ((const f32x4*)p.g_mlp_post)[q], ga = ((const f32x4*)(mr + 5120))[q];
            ((f32x4*)yr)[q] = v[j] + ga * (fv[j] * rstd * gp); }
    }
}

constexpr int N_PHASES = 9;
__global__ void __launch_bounds__(NTHR, 2) fwd_megakernel(Params p) {
    extern __shared__ __attribute__((aligned(16))) unsigned char lds_raw[];
    LAS unsigned char* lds = (LAS unsigned char*)lds_raw;
    cg::grid_group grid = cg::this_grid();
    unsigned char* ws = p.ws;
    const int lo = p.ph_lo, hi = p.ph_hi;
#define IN(k) (lo <= (k) && (k) < hi)
#define SEAM(k) do { if (IN(k) && IN((k) + 1)) grid.sync(); } while (0)
    if (IN(0)) { phase0(p, lds); } SEAM(0);
    if (IN(1)) { phase1(p); } SEAM(1);
    if (IN(2)) {
        pg8::Gemm gm{(const bf16*)(ws + WS_XN), (const bf16*)(ws + WS_WIN), M, NPP, D}; pg8::StaticOrder S; S.init(M, NPP, gridDim.x, (int)blockIdx.x);
        pg8::EpiInProj E{(bf16*)(ws + WS_PROJ), (float*)(ws + WS_GATE), p.out + O_NK, p.out + O_NV, (const float*)(ws + WS_ROPE), (const float*)(ws + WS_ROPE) + 1024};
        pg8::gemm_phase<pg8::EpiInProj, pg8::StaticOrder, true, true>(lds, gm, S, E);
    } SEAM(2);
    if (IN(3)) { phase3(p, lds); } SEAM(3);
    if (IN(4)) {
        phase3b(p);
    } SEAM(4);
    if (IN(5)) {
        pg8::Gemm gm{(const bf16*)(ws + WS_A2), (const bf16*)(ws + WS_WOUT), M, D, D}; pg8::StaticOrder S; S.init(M, D, gridDim.x, (int)blockIdx.x);
        pg8::EpiF32 E{(float*)(ws + WS_MIX), D};
        pg8::gemm_phase<pg8::EpiF32, pg8::StaticOrder, true, true>(lds, gm, S, E);
    } SEAM(5);
    if (IN(6)) { phase5(p); } SEAM(6);
    if (IN(7)) {
        pg8::Gemm gm{(const bf16*)(ws + WS_XN), (const bf16*)(ws + WS_W1), M, FF, D}; pg8::StaticOrder S; S.init(M, FF, gridDim.x, (int)blockIdx.x);
        pg8::EpiRelu2 E{(bf16*)(ws + WS_H), FF};
        pg8::gemm_phase<pg8::EpiRelu2, pg8::StaticOrder, true, true>(lds, gm, S, E);
    } SEAM(7);
    if (IN(8)) {
        pg8::Gemm gm{(const bf16*)(ws + WS_H), (const bf16*)(ws + WS_W2), M, D, FF}; pg8::StaticOrder S; S.init(M, D, gridDim.x, (int)blockIdx.x);
        pg8::EpiF32 E{(float*)(ws + WS_F), D};
        pg8::gemm_phase<pg8::EpiF32, pg8::StaticOrder, true, true>(lds, gm, S, E);
    } SEAM(8);
    if (IN(9)) { phase8(p); }
#undef IN
#undef SEAM
}

extern "C" void kernel_launch(void* const* d_in, const int* in_sizes, int n_in, void* d_out, int out_size, void* d_ws, size_t ws_size, hipStream_t stream) {
    static int grid = 0;
    if (grid == 0) {
        int dev = 0, cus = 0, per_cu = 0;
        hipGetDevice(&dev); hipDeviceGetAttribute(&cus, hipDeviceAttributeMultiprocessorCount, dev);
        if (hipFuncSetAttribute((const void*)fwd_megakernel, hipFuncAttributeMaxDynamicSharedMemorySize, LDS_BYTES) != hipSuccess) { fprintf(stderr, "hipFuncSetAttribute failed\n"); }
        if (hipOccupancyMaxActiveBlocksPerMultiprocessor(&per_cu, (const void*)fwd_megakernel, NTHR, LDS_BYTES) != hipSuccess || per_cu < 1) { fprintf(stderr, "occupancy query: %d\n", per_cu); per_cu = 1; }
        (void)hipGetLastError();
        grid = cus * 1;
        if (grid <= 0) grid = 256;
    }
    Params p{};
    const float* const* in = (const float* const*)d_in;
    p.xp = in[0]; p.xs = in[1]; p.c = in[2]; p.cache_k = in[3]; p.cache_v = in[4]; p.state_f = in[5]; p.state_b = in[6]; p.c_ctx = in[7]; p.w_ada = in[8]; p.b_ada = in[9];
    p.g_attn_pre = in[10]; p.g_attn_post = in[11]; p.g_mlp_pre = in[12]; p.g_mlp_post = in[13]; p.w_in = in[14]; p.wg_f = in[15]; p.bg_f = in[16]; p.wg_b = in[17]; p.bg_b = in[18];
    p.lq1 = in[19]; p.lk1 = in[20]; p.lq2 = in[21]; p.lk2 = in[22]; p.diff_norm = in[23]; p.gla_norm = in[24]; p.w_out = in[25]; p.w_mlp1 = in[26]; p.w_mlp2 = in[27];
    p.out = (float*)d_out; p.ws = (unsigned char*)d_ws;
#if MK_N_LAUNCHES == 1
    p.ph_lo = 0; p.ph_hi = N_PHASES + 1;
    void* args[] = {&p};
    hipError_t e = hipLaunchCooperativeKernel((const void*)fwd_megakernel, dim3(grid), dim3(NTHR), args, LDS_BYTES, stream);
    if (e != hipSuccess) fprintf(stderr, "cooperative launch failed: %s (grid %d)\n", hipGetErrorString(e), grid);
#else
    for (int k = 0; k <= N_PHASES; ++k) { p.ph_lo = k; p.ph_hi = k + 1; hipLaunchKernelGGL(fwd_megakernel, dim3(grid), dim3(NTHR), LDS_BYTES, stream, p); }
#endif
}
```

```cpp
#include <hip/hip_runtime.h>
#include <hip/hip_cooperative_groups.h>
#include <cstdio>
#include <cstdint>
#include <cmath>
namespace cg = cooperative_groups;
namespace pg8 {
#define PG8_LAS __attribute__((address_space(3)))
typedef unsigned short bf16_t;
typedef short bf16x8 __attribute__((ext_vector_type(8)));
typedef float f32x4 __attribute__((ext_vector_type(4)));
typedef unsigned u32x4 __attribute__((ext_vector_type(4)));
constexpr int BM = 256, BK = 64, HALF = 128, HTB = HALF * BK * 2  , STAGE_BYTES = 8 * HTB, NXCD = 8, WGM = 8;

__host__ __device__ __forceinline__ int lds_byte(int r, int c) { const int st = (r >> 4) * 2 + (c >> 5), rr = r & 15, cc = c & 31, ob = rr * 64 + cc * 2; return st * 1024 + (ob ^ (((ob >> 9) & 1) << 5)); }
__host__ __device__ __forceinline__ void stage_rc(int b, int& R, int& C) { const int st = b / 1024, sb = b % 1024, swz = sb ^ (((sb >> 9) & 1) << 5); R = (st >> 1) * 16 + swz / 64; C = (st & 1) * 32 + (swz % 64) / 2; }
__host__ __device__ __forceinline__ int perm32(int rho) { const int n = rho >> 4, i = rho & 15; return 8 * (i >> 2) + 4 * n + (i & 3); }

struct Unit { int pm, pn; };
struct Gemm { const bf16_t* A; const bf16_t* Bt; int M, N, K; };

struct StaticOrder {
    int nM, nN, nwg, G, c;
    __host__ __device__ void init(int M, int N, int G_, int c_) { nM = M / BM; nN = N / BM; nwg = nM * nN; G = G_; c = c_; }
    __host__ __device__ bool next(int i, Unit& u) const {
        const long L = (long)i * G + c; if (L >= nwg) return false;
        int wgid = (int)L; { const int q = nwg / NXCD, r = nwg % NXCD, xcd = wgid % NXCD, off = wgid / NXCD; wgid = (xcd < r ? xcd * (q + 1) : r * (q + 1) + (xcd - r) * q) + off; }
        const int nig = WGM * nN, gid = wgid / nig, fm = gid * WGM, gsz = (nM - fm) < WGM ? (nM - fm) : WGM;
        u.pm = fm + ((wgid % nig) % gsz); u.pn = (wgid % nig) / gsz; return true;
    }
    __device__ __forceinline__ void a_ready(const Unit&) const {}
    __device__ __forceinline__ void done(const Unit&) const {}
};

__device__ __forceinline__ unsigned cvt_pk_bf16(float lo, float hi) { unsigned r; asm volatile("v_cvt_pk_bf16_f32 %0, %1, %2" : "=v"(r) : "v"(lo), "v"(hi)); return r; }
typedef float f32x2 __attribute__((ext_vector_type(2)));
template <class Epi, class Sched, bool ALIGN_EPI = false, bool SP2 = false>
__device__ __forceinline__ void gemm_phase(PG8_LAS unsigned char* lds, const Gemm g, const Sched& S, const Epi& E) {
    const int tid = threadIdx.x, wid = __builtin_amdgcn_readfirstlane(tid >> 6), lane = tid & 63, wr = wid >> 2, wc = wid & 3, fr = lane & 15, fq = lane >> 4;
    const int K = g.K, nt = K / BK;
    unsigned voffA[2], voffB[2];
#pragma unroll
    for (int i = 0; i < 2; ++i) { int R, C; stage_rc(tid * 16 + i * 8192, R, C); const int Rb = Epi::PERM ? ((R & ~31) + perm32(R & 31)) : R;
        voffA[i] = (unsigned)(R * K + C) * 2u; voffB[i] = (unsigned)(Rb * K + C) * 2u; }
    const size_t kstep = (size_t)(BK * 2);
    const size_t hstep = (size_t)HALF * K * 2;
    const size_t tstep = 2 * hstep;
    const unsigned ldsw = (unsigned)wid * 1024u;
    const int aoff = lds_byte(wr * 64 + fr, fq * 8), boff = lds_byte(wc * 32 + fr, fq * 8);
#define PG8_SA(b, h) (((b) * 2 + (h)) * HTB)
#define PG8_SB(b, h) ((4 + (b) * 2 + (h)) * HTB)
#define PG8_STAGE(bufoff, gbase, voff) do { _Pragma("unroll") for (int _i = 0; _i < 2; ++_i) \
        __builtin_amdgcn_global_load_lds((const unsigned*)((const char*)(gbase) + (voff)[_i]), (PG8_LAS unsigned*)(lds + (bufoff) + ldsw + _i * 8192), 16, 0, 0); } while (0)
#define PG8_LDA(dst, b, h) do { _Pragma("unroll") for (int m = 0; m < 4; ++m) _Pragma("unroll") for (int k = 0; k < 2; ++k) dst[m][k] = *(const PG8_LAS bf16x8*)(lds + PG8_SA(b, h) + aoff + m * 2048 + k * 1024); } while (0)
#define PG8_LDB(dst, b, h) do { _Pragma("unroll") for (int n = 0; n < 2; ++n) _Pragma("unroll") for (int k = 0; k < 2; ++k) dst[n][k] = *(const PG8_LAS bf16x8*)(lds + PG8_SB(b, h) + boff + n * 2048 + k * 1024); } while (0)
#define PG8_MMA(ai, bj, At, Bt) do { __builtin_amdgcn_s_setprio(1); _Pragma("unroll") for (int m = 0; m < 4; ++m) _Pragma("unroll") for (int n = 0; n < 2; ++n) _Pragma("unroll") for (int k = 0; k < 2; ++k) \
        acc[ai][bj][m][n] = __builtin_amdgcn_mfma_f32_16x16x32_bf16(Bt[n][k], At[m][k], acc[ai][bj][m][n], 0, 0, 0); __builtin_amdgcn_s_setprio(0); } while (0)
#define PG8_WAIT_V(n) asm volatile("s_waitcnt vmcnt(" #n ")" ::: "memory")
#define PG8_WAIT_L(n) asm volatile("s_waitcnt lgkmcnt(" #n ")" ::: "memory")
#define PG8_BAR __builtin_amdgcn_s_barrier()
#define PG8_SCHED __builtin_amdgcn_sched_barrier(0)
    Unit cur, nxt; int ui = 0;
    if (!S.next(0, cur)) return;
    f32x4 acc[2][2][4][2];
#pragma unroll
    for (int a = 0; a < 2; ++a)
#pragma unroll
        for (int b = 0; b < 2; ++b)
#pragma unroll
            for (int m = 0; m < 4; ++m)
#pragma unroll
                for (int n = 0; n < 2; ++n) acc[a][b][m][n] = (f32x4){0.f, 0.f, 0.f, 0.f};
    bf16x8 At[4][2], B0[2][2], B1[2][2];
    const char* cA = (const char*)g.A + (size_t)cur.pm * tstep; const char* cB = (const char*)g.Bt + (size_t)cur.pn * tstep;
    S.a_ready(cur);
    if constexpr (SP2) {
        PG8_STAGE(PG8_SB(0, 0), cB, voffB); PG8_STAGE(PG8_SB(0, 1), cB + hstep, voffB); PG8_STAGE(PG8_SA(0, 0), cA, voffA); PG8_STAGE(PG8_SA(0, 1), cA + hstep, voffA);
        if (wr == 1) PG8_BAR;
        PG8_WAIT_V(2); PG8_BAR;
        PG8_STAGE(PG8_SB(1, 0), cB + kstep, voffB); PG8_STAGE(PG8_SA(1, 0), cA + kstep, voffA); PG8_STAGE(PG8_SB(1, 1), cB + hstep + kstep, voffB);
        PG8_WAIT_V(6); PG8_BAR;
    } else {
        PG8_STAGE(PG8_SB(0, 0), cB, voffB); PG8_STAGE(PG8_SA(0, 0), cA, voffA); PG8_STAGE(PG8_SB(0, 1), cB + hstep, voffB); PG8_STAGE(PG8_SA(0, 1), cA + hstep, voffA);
        if (wr == 1) PG8_BAR;
        PG8_WAIT_V(4); PG8_BAR;
        PG8_STAGE(PG8_SB(1, 0), cB + kstep, voffB); PG8_STAGE(PG8_SA(1, 0), cA + kstep, voffA); PG8_STAGE(PG8_SB(1, 1), cB + hstep + kstep, voffB);
        PG8_WAIT_V(6); PG8_BAR;
    }
    for (;;) {
        const bool has_next = S.next(ui + 1, nxt);
        const char* nA = has_next ? (const char*)g.A + (size_t)nxt.pm * tstep : cA; const char* nB = has_next ? (const char*)g.Bt + (size_t)nxt.pn * tstep : cB;
        for (int t = 0; t < nt; t += 2) {
            const bool last = (t == nt - 2);
            const char* a1 = cA + (size_t)(t + 1) * kstep;
            const char* a2 = last ? nA : cA + (size_t)(t + 2) * kstep; const char* b2 = last ? nB : cB + (size_t)(t + 2) * kstep;
            const char* a3 = a2 + kstep; const char* b3 = b2 + kstep;
            if (last && has_next) S.a_ready(nxt);
            if constexpr (SP2) {
            PG8_LDB(B0, 0, 0); PG8_LDB(B1, 0, 1); PG8_SCHED; PG8_LDA(At, 0, 0); PG8_STAGE(PG8_SA(1, 1), a1 + hstep, voffA);
            PG8_WAIT_V(8); PG8_WAIT_L(0); PG8_BAR; PG8_MMA(0, 0, At, B0); PG8_MMA(0, 1, At, B1); PG8_BAR; PG8_SCHED;
            PG8_LDA(At, 0, 1); PG8_STAGE(PG8_SB(0, 0), b2, voffB); PG8_STAGE(PG8_SB(0, 1), b2 + hstep, voffB); PG8_STAGE(PG8_SA(0, 0), a2, voffA);
            PG8_WAIT_V(8); PG8_WAIT_L(0); PG8_BAR; PG8_MMA(1, 0, At, B0); PG8_MMA(1, 1, At, B1); PG8_BAR; PG8_SCHED;
            PG8_LDB(B0, 1, 0); PG8_LDB(B1, 1, 1); PG8_SCHED; PG8_LDA(At, 1, 0); PG8_STAGE(PG8_SA(0, 1), a2 + hstep, voffA);
            PG8_WAIT_V(8); PG8_WAIT_L(0); PG8_BAR; PG8_MMA(0, 0, At, B0); PG8_MMA(0, 1, At, B1); PG8_BAR; PG8_SCHED;
            PG8_LDA(At, 1, 1); PG8_STAGE(PG8_SB(1, 0), b3, voffB); PG8_STAGE(PG8_SB(1, 1), b3 + hstep, voffB); PG8_STAGE(PG8_SA(1, 0), a3, voffA);
            PG8_WAIT_V(8); PG8_WAIT_L(0); PG8_BAR; PG8_MMA(1, 0, At, B0); PG8_MMA(1, 1, At, B1); PG8_BAR; PG8_SCHED;
            } else {
            PG8_LDB(B0, 0, 0); PG8_SCHED; PG8_LDA(At, 0, 0); PG8_STAGE(PG8_SA(1, 1), a1 + hstep, voffA);
            PG8_WAIT_L(8); PG8_BAR; PG8_WAIT_L(0); PG8_MMA(0, 0, At, B0); PG8_BAR; PG8_SCHED;
            PG8_LDB(B1, 0, 1); PG8_STAGE(PG8_SB(0, 0), b2, voffB);
            PG8_BAR; PG8_WAIT_L(0); PG8_MMA(0, 1, At, B1); PG8_BAR;
            PG8_LDA(At, 0, 1); PG8_STAGE(PG8_SA(0, 0), a2, voffA);
            PG8_BAR; PG8_WAIT_L(0); PG8_MMA(1, 0, At, B0); PG8_BAR; PG8_SCHED;
            PG8_STAGE(PG8_SB(0, 1), b2 + hstep, voffB);
            PG8_WAIT_V(6); PG8_BAR; PG8_MMA(1, 1, At, B1); PG8_BAR;
            PG8_LDB(B0, 1, 0); PG8_SCHED; PG8_LDA(At, 1, 0); PG8_STAGE(PG8_SA(0, 1), a2 + hstep, voffA);
            PG8_WAIT_L(8); PG8_BAR; PG8_WAIT_L(0); PG8_MMA(0, 0, At, B0); PG8_BAR; PG8_SCHED;
            PG8_LDB(B1, 1, 1); PG8_STAGE(PG8_SB(1, 0), b3, voffB);
            PG8_BAR; PG8_WAIT_L(0); PG8_MMA(0, 1, At, B1); PG8_BAR;
            PG8_LDA(At, 1, 1); PG8_STAGE(PG8_SA(1, 0), a3, voffA);
            PG8_BAR; PG8_WAIT_L(0); PG8_MMA(1, 0, At, B0); PG8_BAR; PG8_SCHED;
            PG8_STAGE(PG8_SB(1, 1), b3 + hstep, voffB);
            PG8_WAIT_V(6); PG8_BAR; PG8_MMA(1, 1, At, B1); PG8_BAR;
            }
        }
        if constexpr (ALIGN_EPI) { if (wr == 0) PG8_BAR; }
        if constexpr (!Epi::AFTER_DRAIN) { E(acc, cur, wr, wc, fr, fq); S.done(cur); }
        if (!has_next) break;
#pragma unroll
        for (int a = 0; a < 2; ++a)
#pragma unroll
            for (int b = 0; b < 2; ++b)
#pragma unroll
                for (int m = 0; m < 4; ++m)
#pragma unroll
                    for (int n = 0; n < 2; ++n) acc[a][b][m][n] = (f32x4){0.f, 0.f, 0.f, 0.f};
        cur = nxt; cA = nA; cB = nB; ++ui;
        if constexpr (ALIGN_EPI) { if (wr == 1) PG8_BAR; }
    }
    PG8_WAIT_V(0);
    if constexpr (!ALIGN_EPI) { if (wr == 0) PG8_BAR; }
    PG8_BAR;
    if constexpr (Epi::AFTER_DRAIN) { E.fused(acc, cur, wr, wc, fr, fq, lds, wid, lane); S.done(cur); }
#undef PG8_SA
#undef PG8_SB
#undef PG8_STAGE
#undef PG8_LDA
#undef PG8_LDB
#undef PG8_MMA
#undef PG8_WAIT_V
#undef PG8_WAIT_L
#undef PG8_BAR
#undef PG8_SCHED
}
}

#ifndef REP_P0
#define REP_P0 1
#endif
#ifndef REP_P2
#define REP_P2 1
#endif
#ifndef REP_ATT
#define REP_ATT 1
#endif
#ifndef REP_GLA
#define REP_GLA 1
#endif
#ifndef REP_P5
#define REP_P5 1
#endif
#ifndef REP_P7
#define REP_P7 1
#endif
#ifndef REP_P8
#define REP_P8 1
#endif
#ifndef USE_CG_SYNC
#define USE_CG_SYNC 0
#endif
#ifndef MK_N_LAUNCHES
#define MK_N_LAUNCHES 1
#endif
#define LAS __attribute__((address_space(3)))
typedef unsigned short bf16;
typedef unsigned v4u __attribute__((ext_vector_type(4)));
typedef unsigned v2u __attribute__((ext_vector_type(2)));
typedef float f32x4 __attribute__((ext_vector_type(4)));
typedef short bf16x8 __attribute__((ext_vector_type(8)));
typedef short s16x4 __attribute__((ext_vector_type(4)));

constexpr int D = 1024, M = 16384, MP = 8192, NPROJ = 3104, NPP = 3328, FF = 4096;
constexpr int C_QA = 0, C_KA = 512, C_VA = 1024, C_QB = 1536, C_KB = 1792, C_VB = 2048, C_RB = 2560, C_GL = 3072;
constexpr float EPS = 1e-6f;
constexpr int NWAVES = 8, NTHR = 512;
constexpr int LDS_BYTES = 147456;

constexpr size_t MiB = 1u << 20;
constexpr size_t WS_WIN = 2 * MiB, WS_WOUT = 9 * MiB, WS_W1 = 11 * MiB, WS_W2 = 19 * MiB;
constexpr size_t WS_MOD = 27 * MiB, WS_ROPE = 27 * MiB + 512 * 1024, WS_CK = 28 * MiB, WS_CV = 30 * MiB;
constexpr size_t WS_XN = 32 * MiB, WS_PROJ = 64 * MiB, WS_GATE = 168 * MiB, WS_A2 = 170 * MiB, WS_OGF = 202 * MiB, WS_OGB = 218 * MiB;
constexpr size_t WS_MIX = 64 * MiB, WS_H = 64 * MiB, WS_F = 192 * MiB;
constexpr size_t O_Y = 0, O_NK = 16777216, O_NV = 20971520, O_SF = 25165824, O_SB = 26214400;

struct Params {
    const float *xp, *xs, *c, *cache_k, *cache_v, *state_f, *state_b, *c_ctx, *w_ada, *b_ada;
    const float *g_attn_pre, *g_attn_post, *g_mlp_pre, *g_mlp_post, *w_in, *wg_f, *bg_f, *wg_b, *bg_b;
    const float *lq1, *lk1, *lq2, *lk2, *diff_norm, *gla_norm, *w_out, *w_mlp1, *w_mlp2;
    float* out; unsigned char* ws;
    int ph_lo, ph_hi;
};

__device__ __forceinline__ unsigned f2bf(float f) { unsigned u = __builtin_bit_cast(unsigned, f); return (u + 0x7fffu + ((u >> 16) & 1u)) >> 16; }
__device__ __forceinline__ unsigned pk2(float lo, float hi) { return f2bf(lo) | (f2bf(hi) << 16); }
__device__ __forceinline__ float bf2f(unsigned short b) { return __builtin_bit_cast(float, (unsigned)b << 16); }
__device__ __forceinline__ float bflo(unsigned w) { return __builtin_bit_cast(float, w << 16); }
__device__ __forceinline__ float bfhi(unsigned w) { return __builtin_bit_cast(float, w & 0xffff0000u); }
__device__ __forceinline__ float wave_sum(float v) {
#pragma unroll
    for (int o = 1; o < 64; o <<= 1) v += __shfl_xor(v, o);
    return v;
}
__device__ __forceinline__ s16x4 trrd(const LAS unsigned char* p) { return __builtin_bit_cast(s16x4, __builtin_amdgcn_ds_read_tr16_b64_v4i16((LAS s16x4*)p)); }
__device__ __forceinline__ bf16x8 cat4(s16x4 lo, s16x4 hi) { return (bf16x8){lo[0], lo[1], lo[2], lo[3], hi[0], hi[1], hi[2], hi[3]}; }
__device__ __forceinline__ bf16x8 pack8(f32x4 a, f32x4 b) { v4u w; w.x = pk2(a[0], a[1]); w.y = pk2(a[2], a[3]); w.z = pk2(b[0], b[1]); w.w = pk2(b[2], b[3]); return __builtin_bit_cast(bf16x8, w); }
#define MFMA16(a, b, c) __builtin_amdgcn_mfma_f32_16x16x32_bf16((a), (b), (c), 0, 0, 0)

namespace pg8 {
struct EpiF32 {
    static constexpr bool PERM = true, AFTER_DRAIN = false;
    float* O; int ldc;
    __device__ __forceinline__ void operator()(const f32x4 (&acc)[2][2][4][2], const Unit& u, int wr, int wc, int fr, int fq) const {
#pragma unroll
        for (int ai = 0; ai < 2; ++ai)
#pragma unroll
            for (int m = 0; m < 4; ++m) { float* rp = O + (size_t)(u.pm * BM + ai * HALF + wr * 64 + m * 16 + fr) * ldc + u.pn * BM + wc * 32 + 8 * fq;
#pragma unroll
                for (int bj = 0; bj < 2; ++bj) { *(f32x4*)(rp + bj * HALF) = acc[ai][bj][m][0]; *(f32x4*)(rp + bj * HALF + 4) = acc[ai][bj][m][1]; } }
    }
};
struct EpiRelu2 {
    static constexpr bool PERM = true, AFTER_DRAIN = false;
    bf16_t* O; int ldc;
    __device__ __forceinline__ void operator()(const f32x4 (&acc)[2][2][4][2], const Unit& u, int wr, int wc, int fr, int fq) const {
#pragma unroll
        for (int ai = 0; ai < 2; ++ai)
#pragma unroll
            for (int m = 0; m < 4; ++m) { bf16_t* rp = O + (size_t)(u.pm * BM + ai * HALF + wr * 64 + m * 16 + fr) * ldc + u.pn * BM + wc * 32 + 8 * fq;
#pragma unroll
                for (int bj = 0; bj < 2; ++bj) { f32x4 a = acc[ai][bj][m][0], b = acc[ai][bj][m][1];
#pragma unroll
                    for (int j = 0; j < 4; ++j) { a[j] = a[j] > 0.f ? a[j] * a[j] : 0.f; b[j] = b[j] > 0.f ? b[j] * b[j] : 0.f; }
                    u32x4 w; w.x = cvt_pk_bf16(a[0], a[1]); w.y = cvt_pk_bf16(a[2], a[3]); w.z = cvt_pk_bf16(b[0], b[1]); w.w = cvt_pk_bf16(b[2], b[3]);
                    *(u32x4*)(rp + bj * HALF) = w; } }
    }
};
struct EpiInProj {
    static constexpr bool PERM = false, AFTER_DRAIN = false;
    bf16_t* P; float* GATE; float* newk; float* newv; const float* COS; const float* SIN;
    __device__ __forceinline__ void operator()(const f32x4 (&acc)[2][2][4][2], const Unit& u, int wr, int wc, int fr, int fq) const {
        typedef unsigned u32x2 __attribute__((ext_vector_type(2)));
        const int pn = u.pn;
#pragma unroll
        for (int ai = 0; ai < 2; ++ai)
#pragma unroll
            for (int m = 0; m < 4; ++m) {
                const int row = u.pm * BM + ai * HALF + wr * 64 + m * 16 + fr;
                const bool samp = row >= 8192;
                const int t = (row - 8192) & 1023;
#pragma unroll
                for (int bj = 0; bj < 2; ++bj) {
                    const int col0 = pn * BM + bj * HALF + wc * 32 + 4 * fq;
                    f32x4 v0 = acc[ai][bj][m][0], v1 = acc[ai][bj][m][1];
                    if (pn < 4 && samp) {
                        const int pos = ((col0 >> 5) & 1) ? (t & 63) : (t >> 6);
                        const f32x4 cs = *(const f32x4*)(COS + pos * 16 + 4 * fq), sn = *(const f32x4*)(SIN + pos * 16 + 4 * fq);
                        const f32x4 o0 = v0 * cs - v1 * sn, o1 = v0 * sn + v1 * cs; v0 = o0; v1 = o1;
                    }
                    if (pn == 12) {
                        if (bj == 0 && wc == 0) { *(f32x4*)(GATE + (size_t)row * 32 + 4 * fq) = v0; *(f32x4*)(GATE + (size_t)row * 32 + 16 + 4 * fq) = v1; }
                    } else {
                        bf16_t* pp = P + (size_t)row * 3328 + col0;
                        u32x2 w0, w1; w0.x = cvt_pk_bf16(v0[0], v0[1]); w0.y = cvt_pk_bf16(v0[2], v0[3]); w1.x = cvt_pk_bf16(v1[0], v1[1]); w1.y = cvt_pk_bf16(v1[2], v1[3]);
                        *(u32x2*)pp = w0; *(u32x2*)(pp + 16) = w1;
                        if (!samp && pn >= 2 && pn < 6) {
                            const int cc = (col0 - 512) & 511, hh = cc >> 7, dd = cc & 127;
                            float* op = (pn < 4 ? newk : newv) + ((size_t)((row >> 8) * 4 + hh) * 256 + (row & 255)) * 128 + dd;
                            *(f32x4*)op = v0; *(f32x4*)(op + 16) = v1;
                        }
                    }
                }
            }
    }
};
}

__device__ __forceinline__ void p0_transpose_item(const float* __restrict__ W, int K, int N, bf16* WT, LAS float* scr, int item, int lane) {
    const int nblk = N / 32, kb = item / nblk, nb = item % nblk, k0 = 64 * kb, n0 = 32 * nb;
#pragma unroll 8
    for (int i = 0; i < 32; ++i) { const int kk = 2 * i + (lane >> 5); scr[kk * 33 + (lane & 31)] = W[(size_t)(k0 + kk) * N + n0 + (lane & 31)]; }
    asm volatile("s_waitcnt lgkmcnt(0)" ::: "memory");
    const int c = lane & 7;
#pragma unroll
    for (int j = 0; j < 4; ++j) { const int n = (lane >> 3) + 8 * j; const LAS float* s = scr + (8 * c) * 33 + n;
        v4u o; o.x = pk2(s[0 * 33], s[1 * 33]); o.y = pk2(s[2 * 33], s[3 * 33]); o.z = pk2(s[4 * 33], s[5 * 33]); o.w = pk2(s[6 * 33], s[7 * 33]);
        *(v4u*)(WT + (size_t)(n0 + n) * K + k0 + 8 * c) = o; }
    asm volatile("s_waitcnt lgkmcnt(0)" ::: "memory");
}
__device__ __forceinline__ void sincos_tab(float ang, float& s, float& c) {
    const double x = (double)ang; const double k = rint(x * 0.15915494309189535);
    double r = fma(-k, 6.283185307179586, x); r = fma(-k, 2.4492935982947064e-16, r);
    const double r2 = r * r; double ts = 1.0, tc = 1.0, ss = 1.0, cc = 1.0;
#pragma unroll
    for (int n = 1; n <= 13; ++n) { tc *= -r2 * (1.0 / (double)((2 * n - 1) * (2 * n))); cc += tc; ts *= -r2 * (1.0 / (double)((2 * n) * (2 * n + 1))); ss += ts; }
    s = (float)(r * ss); c = (float)cc;
}
__device__ __forceinline__ void phase0(const Params& p, LAS unsigned char* lds) {
    const int tid = threadIdx.x, lane = tid & 63, wave = __builtin_amdgcn_readfirstlane(tid >> 6);
    unsigned char* ws = p.ws;
    float* MOD = (float*)(ws + WS_MOD);
    {
        LAS float* Ssil = (LAS float*)lds; LAS float* part = (LAS float*)(lds + 36864);
        bool have = false;
        for (int j = blockIdx.x; j < 96; j += gridDim.x) {
            if (!have) {
                for (int i = tid; i < 9 * 1024; i += NTHR) { const int r = i >> 10, k = i & 1023; const float v = (r == 0) ? p.c_ctx[k] : p.c[(r - 1) * 1024 + k]; Ssil[i] = v / (1.f + __expf(-v)); }
                __syncthreads(); have = true;
            }
            float a0 = 0.f, a1 = 0.f, a2 = 0.f, a3 = 0.f, a4 = 0.f, a5 = 0.f, a6 = 0.f, a7 = 0.f, a8 = 0.f;
            const int col = 64 * j + lane, k0 = wave * 128;
            const float* wp = p.w_ada + (size_t)k0 * 6144 + col;
#pragma unroll 8
            for (int kk = 0; kk < 128; ++kk) {
                const float w = wp[(size_t)kk * 6144]; const LAS float* sp = Ssil + k0 + kk;
                a0 += sp[0] * w; a1 += sp[1024] * w; a2 += sp[2048] * w; a3 += sp[3072] * w; a4 += sp[4096] * w; a5 += sp[5120] * w; a6 += sp[6144] * w; a7 += sp[7168] * w; a8 += sp[8192] * w;
            }
            LAS float* pp = part + wave * 576 + lane;
            pp[0] = a0; pp[64] = a1; pp[128] = a2; pp[192] = a3; pp[256] = a4; pp[320] = a5; pp[384] = a6; pp[448] = a7; pp[512] = a8;
            __syncthreads();
            for (int i = tid; i < 576; i += NTHR) { const int r = i >> 6, ci = i & 63; float s = p.b_ada[64 * j + ci];
#pragma unroll
                for (int w = 0; w < 8; ++w) s += part[w * 576 + i];
                MOD[r * 6144 + 64 * j + ci] = s; }
            __syncthreads();
        }
        __syncthreads();
    }
    if (blockIdx.x == gridDim.x - 1) {
        float* COS = (float*)(ws + WS_ROPE); float* SIN = COS + 1024;
        for (int i = tid; i < 1024; i += NTHR) { const int pos = i >> 4, fi = i & 15; const float inv = exp2f(-(float)fi * (13.287712379549449f / 16.f));
            float s, c; sincos_tab((float)pos * inv, s, c); COS[i] = c; SIN[i] = s; }
    }
    {
        LAS float* scr = (LAS float*)(lds + wave * 16384);
        const int gw = blockIdx.x * NWAVES + wave, NGW = gridDim.x * NWAVES;
        constexpr int I_IN = 16 * 97, I_O = 16 * 32, I_1 = 16 * 128, I_2 = 64 * 32, NIT = I_IN + I_O + I_1 + I_2;
        for (int it = gw; it < NIT; it += NGW) {
            int r = it;
            if (r < I_IN) { p0_transpose_item(p.w_in, 1024, NPROJ, (bf16*)(ws + WS_WIN), scr, r, lane); continue; } r -= I_IN;
            if (r < I_O) { p0_transpose_item(p.w_out, 1024, 1024, (bf16*)(ws + WS_WOUT), scr, r, lane); continue; } r -= I_O;
            if (r < I_1) { p0_transpose_item(p.w_mlp1, 1024, 4096, (bf16*)(ws + WS_W1), scr, r, lane); continue; } r -= I_1;
            p0_transpose_item(p.w_mlp2, 4096, 1024, (bf16*)(ws + WS_W2), scr, r, lane);
        }
    }
    {
        const int gt = blockIdx.x * NTHR + tid, NGT = gridDim.x * NTHR;
        v4u* zp = (v4u*)(ws + WS_WIN + (size_t)NPROJ * 1024 * 2);
        for (int i = gt; i < (NPP - NPROJ) * 1024 * 2 / 16; i += NGT) zp[i] = (v4u){0u, 0u, 0u, 0u};
        const f32x4* ck = (const f32x4*)p.cache_k; const f32x4* cv = (const f32x4*)p.cache_v;
        v2u* ok = (v2u*)(ws + WS_CK); v2u* ov = (v2u*)(ws + WS_CV);
        for (int i = gt; i < 262144; i += NGT) { const f32x4 a = ck[i], b = cv[i]; v2u x, y; x.x = pk2(a[0], a[1]); x.y = pk2(a[2], a[3]); y.x = pk2(b[0], b[1]); y.y = pk2(b[2], b[3]); ok[i] = x; ov[i] = y; }
    }
}

__device__ __forceinline__ void phase1(const Params& p) {
    const int tid = threadIdx.x, lane = tid & 63, wave = tid >> 6;
    const float* MOD = (const float*)(p.ws + WS_MOD); bf16* XN = (bf16*)(p.ws + WS_XN);
    const int gw = blockIdx.x * NWAVES + wave, NGW = gridDim.x * NWAVES;
    for (int row = gw; row < M; row += NGW) {
        const float* xr = row < MP ? p.xp + (size_t)row * D : p.xs + (size_t)(row - MP) * D;
        const int r = row < MP ? 0 : 1 + ((row - MP) >> 10);
        f32x4 v[4]; float s2 = 0.f;
#pragma unroll
        for (int j = 0; j < 4; ++j) { v[j] = ((const f32x4*)xr)[lane + 64 * j]; s2 += (v[j][0] * v[j][0] + v[j][1] * v[j][1]) + (v[j][2] * v[j][2] + v[j][3] * v[j][3]); }
        const float rstd = 1.0f / sqrtf(wave_sum(s2) * (1.f / D) + EPS);
        const float* mr = MOD + r * 6144;
#pragma unroll
        for (int j = 0; j < 4; ++j) { const int q = lane + 64 * j;
            const f32x4 g = ((const f32x4*)p.g_attn_pre)[q], sh = ((const f32x4*)mr)[q], sc = ((const f32x4*)(mr + 1024))[q];
            const f32x4 h = (v[j] * rstd * g) * (sc + 1.0f) + sh;
            v2u w; w.x = pk2(h[0], h[1]); w.y = pk2(h[2], h[3]); ((v2u*)(XN + (size_t)row * D))[q] = w; }
    }
}

constexpr int KP = 272, VP = 288, KT_BYTES = 64 * KP, VT_BYTES = 64 * VP, ABUF = KT_BYTES + VT_BYTES;
constexpr float CS = 0.125f * 1.4426950408889634f;

__device__ __forceinline__ void att_load(const Params& p, int samp, int b, int h, int t, int tid, v4u (&kr)[2], v4u (&vr)[2]) {
    const bf16* PROJ = (const bf16*)(p.ws + WS_PROJ);
#pragma unroll
    for (int i = 0; i < 2; ++i) {
        const int id = tid + 512 * i, r = id >> 4, ch = id & 15;
        const bf16 *kp, *vp;
        if (samp && t < 4) { const size_t o = ((size_t)(b * 4 + h) * 256 + t * 64 + r) * 128 + ch * 8; kp = (const bf16*)(p.ws + WS_CK) + o; vp = (const bf16*)(p.ws + WS_CV) + o; }
        else { const int row = samp ? (MP + b * 1024 + (t - 4) * 64 + r) : (b * 256 + t * 64 + r); const bf16* rp = PROJ + (size_t)row * NPP + h * 128 + ch * 8; kp = rp + C_KA; vp = rp + C_VA; }
        kr[i] = *(const v4u*)kp; vr[i] = *(const v4u*)vp;
    }
}
__device__ __forceinline__ void att_store(LAS unsigned char* buf, int tid, const v4u (&kr)[2], const v4u (&vr)[2]) {
#pragma unroll
    for (int i = 0; i < 2; ++i) { const int id = tid + 512 * i, r = id >> 4, ch = id & 15;
        *(LAS v4u*)(buf + r * KP + ch * 16) = kr[i]; *(LAS v4u*)(buf + KT_BYTES + r * VP + ch * 16) = vr[i]; }
}
__device__ __forceinline__ void softmax_step(f32x4 (&S)[4], float& m, float& l, f32x4 (&O)[8]) {
    float mx = S[0][0];
#pragma unroll
    for (int kb = 0; kb < 4; ++kb)
#pragma unroll
        for (int r = 0; r < 4; ++r) mx = fmaxf(mx, S[kb][r]);
    mx = fmaxf(mx, __shfl_xor(mx, 16)); mx = fmaxf(mx, __shfl_xor(mx, 32));
    const float mnew = fmaxf(m, mx * CS), alpha = __builtin_amdgcn_exp2f(m - mnew); m = mnew;
    float ps = 0.f;
#pragma unroll
    for (int kb = 0; kb < 4; ++kb)
#pragma unroll
        for (int r = 0; r < 4; ++r) { const float pv = __builtin_amdgcn_exp2f(S[kb][r] * CS - mnew); S[kb][r] = pv; ps += pv; }
    l = l * alpha + ps;
#pragma unroll
    for (int c = 0; c < 8; ++c) O[c] = O[c] * alpha;
}
__device__ __forceinline__ void attn_unit(const Params& p, LAS unsigned char* lds, int samp, int b, int h, int qb, float lam) {
    const int tid = threadIdx.x, lane = tid & 63, wave = __builtin_amdgcn_readfirstlane(tid >> 6), g = lane >> 4, fr = lane & 15;
    const bf16* PROJ = (const bf16*)(p.ws + WS_PROJ);
    const int rowbase = samp ? MP + b * 1024 : b * 256, NT = samp ? 20 : 4;
    const int qrow = rowbase + qb * 128 + wave * 16 + fr;
    bf16x8 Qf[4];
#pragma unroll
    for (int ds = 0; ds < 4; ++ds) Qf[ds] = *(const bf16x8*)(PROJ + (size_t)qrow * NPP + C_QA + h * 128 + 32 * ds + 8 * g);
    f32x4 O1[8], O2[8];
#pragma unroll
    for (int c = 0; c < 8; ++c) { O1[c] = (f32x4){0.f, 0.f, 0.f, 0.f}; O2[c] = (f32x4){0.f, 0.f, 0.f, 0.f}; }
    float m1 = -INFINITY, m2 = -INFINITY, l1 = 0.f, l2 = 0.f;
    v4u kr[2], vr[2];
    att_load(p, samp, b, h, 0, tid, kr, vr);
    att_store(lds, tid, kr, vr);
    __syncthreads();
    for (int t = 0; t < NT; ++t) {
        const LAS unsigned char* Kb = lds + (t & 1) * ABUF; const LAS unsigned char* Vb = Kb + KT_BYTES;
        if (t + 1 < NT) att_load(p, samp, b, h, t + 1, tid, kr, vr);
        f32x4 S1[4], S2[4];
#pragma unroll
        for (int kb = 0; kb < 4; ++kb) {
            const LAS unsigned char* kp = Kb + (16 * kb + fr) * KP + 16 * g;
            const bf16x8 k0 = *(const LAS bf16x8*)kp, k1 = *(const LAS bf16x8*)(kp + 64), k2 = *(const LAS bf16x8*)(kp + 128), k3 = *(const LAS bf16x8*)(kp + 192);
            f32x4 z = (f32x4){0.f, 0.f, 0.f, 0.f};
            S1[kb] = MFMA16(k0, Qf[0], z); S1[kb] = MFMA16(k1, Qf[1], S1[kb]);
            S2[kb] = MFMA16(k2, Qf[2], z); S2[kb] = MFMA16(k3, Qf[3], S2[kb]);
        }
        softmax_step(S1, m1, l1, O1);
        softmax_step(S2, m2, l2, O2);
        bf16x8 P1[2], P2[2];
#pragma unroll
        for (int kk = 0; kk < 2; ++kk) { P1[kk] = pack8(S1[2 * kk], S1[2 * kk + 1]); P2[kk] = pack8(S2[2 * kk], S2[2 * kk + 1]); }
        const LAS unsigned char* vb = Vb + (4 * g + (fr >> 2)) * VP + 8 * (fr & 3);
#pragma unroll
        for (int kk = 0; kk < 2; ++kk)
#pragma unroll
            for (int c = 0; c < 8; ++c) {
                const s16x4 lo = trrd(vb + kk * 32 * VP + c * 32), hi = trrd(vb + kk * 32 * VP + 16 * VP + c * 32);
                const bf16x8 vf = cat4(lo, hi);
                O1[c] = MFMA16(vf, P1[kk], O1[c]); O2[c] = MFMA16(vf, P2[kk], O2[c]);
            }
        if (t + 1 < NT) att_store(lds + ((t + 1) & 1) * ABUF, tid, kr, vr);
        __syncthreads();
    }
    l1 += __shfl_xor(l1, 16); l1 += __shfl_xor(l1, 32); l2 += __shfl_xor(l2, 16); l2 += __shfl_xor(l2, 32);
    const float i1 = 1.0f / l1, i2 = lam / l2; float ss = 0.f;
#pragma unroll
    for (int c = 0; c < 8; ++c) { O1[c] = O1[c] * i1 - O2[c] * i2; ss += (O1[c][0] * O1[c][0] + O1[c][1] * O1[c][1]) + (O1[c][2] * O1[c][2] + O1[c][3] * O1[c][3]); }
    ss += __shfl_xor(ss, 16); ss += __shfl_xor(ss, 32);
    const float rstd = (1.0f / sqrtf(ss * (1.f / 128.f) + EPS)) * 0.8f;
    bf16* A2 = (bf16*)(p.ws + WS_A2) + (size_t)qrow * D + h * 128 + 4 * g;
#pragma unroll
    for (int c = 0; c < 8; ++c) { const f32x4 dn = *(const f32x4*)(p.diff_norm + 16 * c + 4 * g); const f32x4 o = O1[c] * rstd * dn;
        v2u w; w.x = pk2(o[0], o[1]); w.y = pk2(o[2], o[3]); *(v2u*)(A2 + 16 * c) = w; }
}

constexpr int QP = 144, HP = 160;
constexpr int G_QT = 0, G_KT = 64 * QP, G_KH = 2 * 64 * QP, G_VT = G_KH + 64 * HP, G_BL = G_VT + 64 * HP, G_WG = G_BL + 256, G_BG = G_WG + 4096, G_END = G_BG + 256;
__device__ __forceinline__ float logsig(float x) { return fminf(x, 0.f) - __logf(1.f + __expf(-fabsf(x))); }

__device__ __forceinline__ void gla_unit(const Params& p, LAS unsigned char* lds, int samp, int b, int h, int dir, int dvh) {
    const int tid = threadIdx.x, lane = tid & 63, wave = __builtin_amdgcn_readfirstlane(tid >> 6), g = lane >> 4, fr = lane & 15;
    const bf16* PROJ = (const bf16*)(p.ws + WS_PROJ); const float* GATE = (const float*)(p.ws + WS_GATE);
    bf16* OG = (bf16*)(p.ws + (dir ? WS_OGB : WS_OGF));
    const int L = samp ? 1024 : 256, NC = L / 64, rowbase = samp ? MP + b * 1024 : b * 256;
    const int c = wave & 3, ah = wave >> 2;
    LAS float* WgL = (LAS float*)(lds + G_WG); LAS float* BgL = (LAS float*)(lds + G_BG); LAS float* BL = (LAS float*)(lds + G_BL);
    {
        const float* wg = dir ? p.wg_b : p.wg_f; const float* bg = dir ? p.bg_b : p.bg_f;
        for (int i = tid; i < 1024; i += NTHR) WgL[i] = wg[(i >> 6) * 256 + h * 64 + (i & 63)];
        if (tid < 64) BgL[tid] = bg[h * 64 + tid];
    }
    f32x4 S[4];
    if (samp) { const float* st = (dir ? p.state_b : p.state_f) + (size_t)(b * 4 + h) * 64 * 128 + dvh * 64 + 16 * c + fr;
#pragma unroll
        for (int kb = 0; kb < 4; ++kb)
#pragma unroll
            for (int r = 0; r < 4; ++r) S[kb][r] = st[(16 * kb + 4 * g + r) * 128]; }
    else {
#pragma unroll
        for (int kb = 0; kb < 4; ++kb) S[kb] = (f32x4){0.f, 0.f, 0.f, 0.f}; }
    __syncthreads();
    for (int ch = 0; ch < NC; ++ch) {
        {
            const int tpos = ch * 64 + lane, tok = dir ? (L - 1 - tpos) : tpos, row = rowbase + tok;
            const float* gp = GATE + (size_t)row * 32 + dir * 16;
            const f32x4 g0 = *(const f32x4*)gp, g1 = *(const f32x4*)(gp + 4), g2 = *(const f32x4*)(gp + 8), g3 = *(const f32x4*)(gp + 12);
            const bf16* rp = PROJ + (size_t)row * NPP;
            const v4u qw = *(const v4u*)(rp + C_QB + h * 64 + 8 * wave), kw = *(const v4u*)(rp + C_KB + h * 64 + 8 * wave);
            const v4u vw = *(const v4u*)(rp + C_VB + h * 128 + dvh * 64 + 8 * wave);
            float gl[16] = {g0[0], g0[1], g0[2], g0[3], g1[0], g1[1], g1[2], g1[3], g2[0], g2[1], g2[2], g2[3], g3[0], g3[1], g3[2], g3[3]};
            float x[8];
#pragma unroll
            for (int e = 0; e < 8; ++e) x[e] = BgL[8 * wave + e];
#pragma unroll
            for (int j = 0; j < 16; ++j) { const f32x4 wa = *(const LAS f32x4*)(WgL + j * 64 + 8 * wave), wb = *(const LAS f32x4*)(WgL + j * 64 + 8 * wave + 4);
#pragma unroll
                for (int e = 0; e < 4; ++e) { x[e] += gl[j] * wa[e]; x[4 + e] += gl[j] * wb[e]; } }
            float qf[8], kf[8];
#pragma unroll
            for (int e = 0; e < 4; ++e) { const unsigned a = qw[e], bb = kw[e]; qf[2 * e] = bflo(a); qf[2 * e + 1] = bfhi(a); kf[2 * e] = bflo(bb); kf[2 * e + 1] = bfhi(bb); }
            float qt[8], kt[8], kh[8];
#pragma unroll
            for (int e = 0; e < 8; ++e) {
                float v = logsig(x[e]) * (1.f / 16.f);
#pragma unroll
                for (int o = 1; o < 64; o <<= 1) { const float u = __shfl_up(v, o); if (lane >= o) v += u; }
                const float blast = __shfl(v, 63);
                qt[e] = qf[e] * 0.125f * __expf(v); kt[e] = kf[e] * __expf(-v); kh[e] = kf[e] * __expf(blast - v);
                if (lane == 63) BL[8 * wave + e] = __expf(blast);
            }
            v4u w;
            w.x = pk2(qt[0], qt[1]); w.y = pk2(qt[2], qt[3]); w.z = pk2(qt[4], qt[5]); w.w = pk2(qt[6], qt[7]); *(LAS v4u*)(lds + G_QT + lane * QP + 16 * wave) = w;
            w.x = pk2(kt[0], kt[1]); w.y = pk2(kt[2], kt[3]); w.z = pk2(kt[4], kt[5]); w.w = pk2(kt[6], kt[7]); *(LAS v4u*)(lds + G_KT + lane * QP + 16 * wave) = w;
            w.x = pk2(kh[0], kh[1]); w.y = pk2(kh[2], kh[3]); w.z = pk2(kh[4], kh[5]); w.w = pk2(kh[6], kh[7]); *(LAS v4u*)(lds + G_KH + lane * HP + 16 * wave) = w;
            *(LAS v4u*)(lds + G_VT + lane * HP + 16 * wave) = vw;
        }
        __syncthreads();
        const LAS unsigned char* vtb = lds + G_VT + 32 * c + 8 * (fr & 3);
#pragma unroll
        for (int ai = 0; ai < 2; ++ai) {
            const int a = 2 * ah + ai;
            f32x4 at[4];
#pragma unroll
            for (int sb = 0; sb < 4; ++sb) {
                at[sb] = (f32x4){0.f, 0.f, 0.f, 0.f};
                if (sb <= a) {
#pragma unroll
                    for (int ks = 0; ks < 2; ++ks) { const bf16x8 kfr = *(const LAS bf16x8*)(lds + G_KT + (16 * sb + fr) * QP + 64 * ks + 16 * g);
                        const bf16x8 qfr = *(const LAS bf16x8*)(lds + G_QT + (16 * a + fr) * QP + 64 * ks + 16 * g);
                        at[sb] = MFMA16(kfr, qfr, at[sb]); }
                    if (sb == a) {
#pragma unroll
                        for (int r = 0; r < 4; ++r) if (4 * g + r > fr) at[sb][r] = 0.f; }
                }
            }
            f32x4 o = (f32x4){0.f, 0.f, 0.f, 0.f};
#pragma unroll
            for (int ks = 0; ks < 2; ++ks) {
                const LAS unsigned char* qp = lds + G_QT + (16 * a + fr) * QP + (32 * ks + 4 * g) * 2;
                const v2u lo = *(const LAS v2u*)qp, hi = *(const LAS v2u*)(qp + 32);
                const v4u aw = (v4u){lo.x, lo.y, hi.x, hi.y};
                o = MFMA16(__builtin_bit_cast(bf16x8, aw), pack8(S[2 * ks], S[2 * ks + 1]), o);
            }
#pragma unroll
            for (int ss = 0; ss < 2; ++ss) {
                if (2 * ss <= a) {
                    const s16x4 lo = trrd(vtb + (32 * ss + 4 * g + (fr >> 2)) * HP), hi = trrd(vtb + (32 * ss + 16 + 4 * g + (fr >> 2)) * HP);
                    o = MFMA16(pack8(at[2 * ss], at[2 * ss + 1]), cat4(lo, hi), o);
                }
            }
#pragma unroll
            for (int r = 0; r < 4; ++r) { const int tpos = ch * 64 + 16 * a + 4 * g + r, tok = dir ? (L - 1 - tpos) : tpos;
                OG[(size_t)(rowbase + tok) * 512 + h * 128 + dvh * 64 + 16 * c + fr] = (bf16)f2bf(o[r]); }
        }
        {
            bf16x8 vfr[2];
#pragma unroll
            for (int ts = 0; ts < 2; ++ts) { const s16x4 lo = trrd(vtb + (32 * ts + 8 * g + (fr >> 2)) * HP), hi = trrd(vtb + (32 * ts + 8 * g + 4 + (fr >> 2)) * HP); vfr[ts] = cat4(lo, hi); }
#pragma unroll
            for (int kb = 0; kb < 4; ++kb) {
                const f32x4 dc = *(const LAS f32x4*)(BL + 16 * kb + 4 * g);
                S[kb] = S[kb] * dc;
#pragma unroll
                for (int ts = 0; ts < 2; ++ts) {
                    const LAS unsigned char* kp = lds + G_KH + (32 * ts + 8 * g + (fr >> 2)) * HP + 32 * kb + 8 * (fr & 3);
                    const s16x4 lo = trrd(kp), hi = trrd(kp + 4 * HP);
                    S[kb] = MFMA16(cat4(lo, hi), vfr[ts], S[kb]);
                }
            }
        }
        __syncthreads();
    }
    if (!samp && ah == 0) {
        float* so = p.out + (dir ? O_SB : O_SF) + (size_t)(b * 4 + h) * 64 * 128 + dvh * 64 + 16 * c + fr;
#pragma unroll
        for (int kb = 0; kb < 4; ++kb)
#pragma unroll
            for (int r = 0; r < 4; ++r) so[(16 * kb + 4 * g + r) * 128] = S[kb][r];
    }
}

__device__ __forceinline__ void phase3(const Params& p, LAS unsigned char* lds) {
    const int lane = threadIdx.x & 63;
    float lam;
    { const float a = wave_sum(p.lq1[lane] * p.lk1[lane]), b = wave_sum(p.lq2[lane] * p.lk2[lane]); lam = __expf(a) - __expf(b) + 0.2f; }
    for (int rep = 0; rep < REP_ATT; ++rep) {
    for (int u = blockIdx.x; u < 256; u += gridDim.x) attn_unit(p, lds, 0, u >> 3, (u >> 1) & 3, u & 1, lam);
    for (int u = blockIdx.x; u < 256; u += gridDim.x) attn_unit(p, lds, 1, u >> 5, (u >> 3) & 3, u & 7, lam);
    }
    __syncthreads();
    for (int rep = 0; rep < REP_GLA; ++rep)
    for (int u = blockIdx.x; u < 256; u += gridDim.x) {
        if (u < 128) gla_unit(p, lds, 1, u >> 4, (u >> 2) & 3, (u >> 1) & 1, u & 1);
        else { for (int i = 0; i < 4; ++i) { const int pu = (u - 128) * 4 + i; gla_unit(p, lds, 0, pu >> 4, (pu >> 2) & 3, (pu >> 1) & 1, pu & 1); } }
    }
}

__device__ __forceinline__ void phase3b(const Params& p) {
    const int tid = threadIdx.x, lane = tid & 63, wave = tid >> 6;
    const bf16* PROJ = (const bf16*)(p.ws + WS_PROJ); const bf16* OGF = (const bf16*)(p.ws + WS_OGF); const bf16* OGB = (const bf16*)(p.ws + WS_OGB);
    bf16* A2 = (bf16*)(p.ws + WS_A2);
    const int gw = blockIdx.x * NWAVES + wave, NGW = gridDim.x * NWAVES;
    const f32x4 n0 = *(const f32x4*)(p.gla_norm + 8 * (lane & 15)), n1 = *(const f32x4*)(p.gla_norm + 8 * (lane & 15) + 4);
    for (int row = gw; row < M; row += NGW) {
        const v4u a = *(const v4u*)(OGF + (size_t)row * 512 + 8 * lane), bq = *(const v4u*)(OGB + (size_t)row * 512 + 8 * lane);
        const v4u rw = *(const v4u*)(PROJ + (size_t)row * NPP + C_RB + 8 * lane);
        float o[8], rr[8]; float ss = 0.f;
#pragma unroll
        for (int e = 0; e < 4; ++e) { o[2 * e] = bflo(a[e]) + bflo(bq[e]); o[2 * e + 1] = bfhi(a[e]) + bfhi(bq[e]); rr[2 * e] = bflo(rw[e]); rr[2 * e + 1] = bfhi(rw[e]); }
#pragma unroll
        for (int e = 0; e < 8; ++e) ss += o[e] * o[e];
        ss += __shfl_xor(ss, 1); ss += __shfl_xor(ss, 2); ss += __shfl_xor(ss, 4); ss += __shfl_xor(ss, 8);
        const float rstd = 1.0f / sqrtf(ss * (1.f / 128.f) + EPS);
        float y[8];
#pragma unroll
        for (int e = 0; e < 8; ++e) { const float nw = e < 4 ? n0[e] : n1[e - 4]; const float sl = rr[e] / (1.f + __expf(-rr[e])); y[e] = o[e] * rstd * nw * sl; }
        v4u w; w.x = pk2(y[0], y[1]); w.y = pk2(y[2], y[3]); w.z = pk2(y[4], y[5]); w.w = pk2(y[6], y[7]);
        *(v4u*)(A2 + (size_t)row * D + 512 + 8 * lane) = w;
    }
}

__device__ __forceinline__ void phase5(const Params& p) {
    const int tid = threadIdx.x, lane = tid & 63, wave = tid >> 6;
    const float* MOD = (const float*)(p.ws + WS_MOD); bf16* XN = (bf16*)(p.ws + WS_XN); const float* MIX = (const float*)(p.ws + WS_MIX);
    const int gw = blockIdx.x * NWAVES + wave, NGW = gridDim.x * NWAVES;
    for (int row = gw; row < M; row += NGW) {
        const float* xr = row < MP ? p.xp + (size_t)row * D : p.xs + (size_t)(row - MP) * D;
        const int r = row < MP ? 0 : 1 + ((row - MP) >> 10);
        const float* mr = MOD + r * 6144;
        f32x4 v[4], mv[4]; float s2 = 0.f;
#pragma unroll
        for (int j = 0; j < 4; ++j) { mv[j] = ((const f32x4*)(MIX + (size_t)row * D))[lane + 64 * j]; v[j] = ((const f32x4*)xr)[lane + 64 * j]; s2 += (mv[j][0] * mv[j][0] + mv[j][1] * mv[j][1]) + (mv[j][2] * mv[j][2] + mv[j][3] * mv[j][3]); }
        const float rstd = 1.0f / sqrtf(wave_sum(s2) * (1.f / D) + EPS);
        float t2 = 0.f;
#pragma unroll
        for (int j = 0; j < 4; ++j) { const int q = lane + 64 * j;
            const f32x4 gp = ((const f32x4*)p.g_attn_post)[q], ga = ((const f32x4*)(mr + 2048))[q];
            v[j] = v[j] + ga * (mv[j] * rstd * gp);
            ((f32x4*)(p.out + O_Y + (size_t)row * D))[q] = v[j];
            t2 += (v[j][0] * v[j][0] + v[j][1] * v[j][1]) + (v[j][2] * v[j][2] + v[j][3] * v[j][3]); }
        const float rstd2 = 1.0f / sqrtf(wave_sum(t2) * (1.f / D) + EPS);
#pragma unroll
        for (int j = 0; j < 4; ++j) { const int q = lane + 64 * j;
            const f32x4 g = ((const f32x4*)p.g_mlp_pre)[q], sh = ((const f32x4*)(mr + 3072))[q], sc = ((const f32x4*)(mr + 4096))[q];
            const f32x4 h = (v[j] * rstd2 * g) * (sc + 1.0f) + sh;
            v2u w; w.x = pk2(h[0], h[1]); w.y = pk2(h[2], h[3]); ((v2u*)(XN + (size_t)row * D))[q] = w; }
    }
}
__device__ __forceinline__ void phase8(const Params& p) {
    const int tid = threadIdx.x, lane = tid & 63, wave = tid >> 6;
    const float* MOD = (const float*)(p.ws + WS_MOD); const float* F = (const float*)(p.ws + WS_F);
    const int gw = blockIdx.x * NWAVES + wave, NGW = gridDim.x * NWAVES;
    for (int row = gw; row < M; row += NGW) {
        const int r = row < MP ? 0 : 1 + ((row - MP) >> 10);
        const float* mr = MOD + r * 6144; float* yr = p.out + O_Y + (size_t)row * D;
        f32x4 v[4], fv[4]; float s2 = 0.f;
#pragma unroll
        for (int j = 0; j < 4; ++j) { fv[j] = ((const f32x4*)(F + (size_t)row * D))[lane + 64 * j]; v[j] = ((const f32x4*)yr)[lane + 64 * j]; s2 += (fv[j][0] * fv[j][0] + fv[j][1] * fv[j][1]) + (fv[j][2] * fv[j][2] + fv[j][3] * fv[j][3]); }
        const float rstd = 1.0f / sqrtf(wave_sum(s2) * (1.f / D) + EPS);
#pragma unroll
        for (int j = 0; j < 4; ++j) { const int q = lane + 64 * j;
            const f32x4 gp = ((const f32x4*)p.g_mlp_post)[q], ga = ((const f32x4*)(mr + 5120))[q];
            ((f32x4*)yr)[q] = v[j] + ga * (fv[j] * rstd * gp); }
    }
}

#define RLX_AGENT __ATOMIC_RELAXED, __HIP_MEMORY_SCOPE_AGENT
#define XB_TMO      128
#define XB_XCNT(j)  (256  + 64 * (j))
#define XB_XSUB(j)  (1280 + 64 * (j))
#define XB_XGEN(j)  (2304 + 64 * (j))
#define XB_TOP      3328
#define XB_TOPGEN   3392
#define XCD_BAR_WORDS 3456
#define XB_SPIN_CAP (1u << 18)

__device__ __forceinline__ unsigned xb_ld(unsigned* p)              { return __hip_atomic_load(p, __ATOMIC_RELAXED, __HIP_MEMORY_SCOPE_AGENT); }
__device__ __forceinline__ unsigned xb_add(unsigned* p, unsigned v) { return __hip_atomic_fetch_add(p, v, __ATOMIC_RELAXED, __HIP_MEMORY_SCOPE_AGENT); }
__device__ __forceinline__ unsigned xb_xcc_id() { return (unsigned)__builtin_amdgcn_s_getreg((3 << 11) | 20) & 0xFu; }
#define XB_SPIN(cond, bar) do { unsigned _sp = 0; while (cond) { __builtin_amdgcn_s_sleep(1); \
    if ((++_sp & 255u) == 0u) { if (xb_ld(&(bar)[XB_TMO])) break; if (_sp > XB_SPIN_CAP) { atomicAdd(&(bar)[XB_TMO], 1u); break; } } } } while (0)

struct XcdBarrier {
    unsigned* bar; unsigned x;
    volatile LAS unsigned* st;
};

__device__ __forceinline__ XcdBarrier xcd_barrier_post(unsigned* bar, volatile LAS unsigned* st) {
    XcdBarrier b; b.bar = bar; b.x = xb_xcc_id(); b.st = st;
    if (threadIdx.x == 0) (void)xb_add(&bar[XB_XCNT(b.x)], 1u);
    return b;
}
__device__ __forceinline__ void xcd_barrier_complete(unsigned* bar, unsigned x, unsigned& nloc, unsigned& nx) {
    const unsigned G = gridDim.x * gridDim.y * gridDim.z;
    unsigned sum, cnt, mine, sp = 0u;
    for (;;) {
        sum = 0u; cnt = 0u; mine = 0u;
#pragma unroll
        for (unsigned j = 0; j < 16; ++j) { const unsigned c = xb_ld(&bar[XB_XCNT(j)]); sum += c; cnt += (c > 0u) ? 1u : 0u; mine = (j == x) ? c : mine; }
        if (sum == G) break;
        __builtin_amdgcn_s_sleep(1);
        if ((++sp & 255u) == 0u) { if (xb_ld(&bar[XB_TMO])) break; if (sp > XB_SPIN_CAP) { atomicAdd(&bar[XB_TMO], 1u); break; } }
    }
    nloc = mine > 0u ? mine : 1u; nx = cnt > 0u ? cnt : 1u;
}

__device__ __forceinline__ void xcd_barrier(const XcdBarrier& b) {
    asm volatile("s_waitcnt vmcnt(0)" ::: "memory");
    __syncthreads();
    if (threadIdx.x == 0) {
        unsigned* bar = b.bar;
        __builtin_amdgcn_s_waitcnt(0);
        unsigned nloc = b.st[0], nx = b.st[1];
        if (nloc == 0u) { xcd_barrier_complete(bar, b.x, nloc, nx); b.st[0] = nloc; b.st[1] = nx; }
        const unsigned old = xb_add(&bar[XB_XSUB(b.x)], 1u);
        const unsigned gen = old / nloc;
        if (old + 1u == (gen + 1u) * nloc) {
            __builtin_amdgcn_fence(__ATOMIC_RELEASE, "agent");
            asm volatile("s_waitcnt vmcnt(0)" ::: "memory");
            const unsigned og = xb_add(&bar[XB_TOP], 1u);
            const unsigned tg = og / nx;
            if (og + 1u == (tg + 1u) * nx) xb_add(&bar[XB_TOPGEN], 1u);
            else XB_SPIN(xb_ld(&bar[XB_TOPGEN]) == tg, bar);
            __builtin_amdgcn_fence(__ATOMIC_ACQUIRE, "agent");
            xb_add(&bar[XB_XGEN(b.x)], 1u);
            asm volatile("s_waitcnt vmcnt(0)" ::: "memory");
        } else {
            XB_SPIN(xb_ld(&bar[XB_XGEN(b.x)]) == gen, bar);
            __builtin_amdgcn_fence(__ATOMIC_ACQUIRE, "agent");
            asm volatile("s_waitcnt vmcnt(0)" ::: "memory");
        }
    }
    __syncthreads();
}

constexpr int N_PHASES = 9;
__global__ void __launch_bounds__(NTHR, 2) fwd_megakernel(Params p) {
    extern __shared__ __attribute__((aligned(16))) unsigned char lds_raw[];
    LAS unsigned char* lds = (LAS unsigned char*)lds_raw;
    cg::grid_group grid = cg::this_grid();
    unsigned char* ws = p.ws;
    const int lo = p.ph_lo, hi = p.ph_hi;
    for (int u = threadIdx.x; u < 64; u += NTHR) ((LAS unsigned*)(lds + 131072))[u] = 0u;
    __syncthreads();
    XcdBarrier bar = xcd_barrier_post((unsigned*)ws + 4096, (volatile LAS unsigned*)(lds + 131072));
#define IN(k) (lo <= (k) && (k) < hi)
#ifndef REP_SYNC
#define REP_SYNC 1
#endif
#define SEAM(k) do { if (IN(k) && IN((k) + 1)) { for (int rs = 0; rs < REP_SYNC; ++rs) { if (USE_CG_SYNC || p.ph_lo == 12345) grid.sync(); else xcd_barrier(bar); } } } while (0)
    if (IN(0)) { for (int rep = 0; rep < REP_P0; ++rep) { phase0(p, lds); __syncthreads(); } } SEAM(0);
    if (IN(1)) { phase1(p); } SEAM(1);
    if (IN(2)) _Pragma("unroll") for (int rep = 0; rep < REP_P2; ++rep) {
        pg8::Gemm gm{(const bf16*)(ws + WS_XN), (const bf16*)(ws + WS_WIN), M, NPP, D}; pg8::StaticOrder S; S.init(M, NPP, gridDim.x, (int)blockIdx.x);
        pg8::EpiInProj E{(bf16*)(ws + WS_PROJ), (float*)(ws + WS_GATE), p.out + O_NK, p.out + O_NV, (const float*)(ws + WS_ROPE), (const float*)(ws + WS_ROPE) + 1024};
        pg8::gemm_phase<pg8::EpiInProj, pg8::StaticOrder, true, true>(lds, gm, S, E);
    } SEAM(2);
    if (IN(3)) { phase3(p, lds); } SEAM(3);
    if (IN(4)) {
        phase3b(p);
    } SEAM(4);
    if (IN(5)) _Pragma("unroll") for (int rep = 0; rep < REP_P5; ++rep) {
        pg8::Gemm gm{(const bf16*)(ws + WS_A2), (const bf16*)(ws + WS_WOUT), M, D, D}; pg8::StaticOrder S; S.init(M, D, gridDim.x, (int)blockIdx.x);
        pg8::EpiF32 E{(float*)(ws + WS_MIX), D};
        pg8::gemm_phase<pg8::EpiF32, pg8::StaticOrder, true, true>(lds, gm, S, E);
    } SEAM(5);
    if (IN(6)) { phase5(p); } SEAM(6);
    if (IN(7)) _Pragma("unroll") for (int rep = 0; rep < REP_P7; ++rep) {
        pg8::Gemm gm{(const bf16*)(ws + WS_XN), (const bf16*)(ws + WS_W1), M, FF, D}; pg8::StaticOrder S; S.init(M, FF, gridDim.x, (int)blockIdx.x);
        pg8::EpiRelu2 E{(bf16*)(ws + WS_H), FF};
        pg8::gemm_phase<pg8::EpiRelu2, pg8::StaticOrder, true, true>(lds, gm, S, E);
    } SEAM(7);
    if (IN(8)) _Pragma("unroll") for (int rep = 0; rep < REP_P8; ++rep) {
        pg8::Gemm gm{(const bf16*)(ws + WS_H), (const bf16*)(ws + WS_W2), M, D, FF}; pg8::StaticOrder S; S.init(M, D, gridDim.x, (int)blockIdx.x);
        pg8::EpiF32 E{(float*)(ws + WS_F), D};
        pg8::gemm_phase<pg8::EpiF32, pg8::StaticOrder, true, true>(lds, gm, S, E);
    } SEAM(8);
    if (IN(9)) { phase8(p); }
#undef IN
#undef SEAM
}

extern "C" void kernel_launch(void* const* d_in, const int* in_sizes, int n_in, void* d_out, int out_size, void* d_ws, size_t ws_size, hipStream_t stream) {
    static int grid = 0;
    if (grid == 0) {
        int dev = 0, cus = 0, per_cu = 0;
        hipGetDevice(&dev); hipDeviceGetAttribute(&cus, hipDeviceAttributeMultiprocessorCount, dev);
        if (hipFuncSetAttribute((const void*)fwd_megakernel, hipFuncAttributeMaxDynamicSharedMemorySize, LDS_BYTES) != hipSuccess) { fprintf(stderr, "hipFuncSetAttribute failed\n"); }
        if (hipOccupancyMaxActiveBlocksPerMultiprocessor(&per_cu, (const void*)fwd_megakernel, NTHR, LDS_BYTES) != hipSuccess || per_cu < 1) { fprintf(stderr, "occupancy query: %d\n", per_cu); per_cu = 1; }
        (void)hipGetLastError();
        grid = cus * 1;
        if (grid <= 0) grid = 256;
    }
    if (hipMemsetAsync(d_ws, 0, 65536, stream) != hipSuccess) fprintf(stderr, "memset failed\n");
    Params p{};
    const float* const* in = (const float* const*)d_in;
    p.xp = in[0]; p.xs = in[1]; p.c = in[2]; p.cache_k = in[3]; p.cache_v = in[4]; p.state_f = in[5]; p.state_b = in[6]; p.c_ctx = in[7]; p.w_ada = in[8]; p.b_ada = in[9];
    p.g_attn_pre = in[10]; p.g_attn_post = in[11]; p.g_mlp_pre = in[12]; p.g_mlp_post = in[13]; p.w_in = in[14]; p.wg_f = in[15]; p.bg_f = in[16]; p.wg_b = in[17]; p.bg_b = in[18];
    p.lq1 = in[19]; p.lk1 = in[20]; p.lq2 = in[21]; p.lk2 = in[22]; p.diff_norm = in[23]; p.gla_norm = in[24]; p.w_out = in[25]; p.w_mlp1 = in[26]; p.w_mlp2 = in[27];
    p.out = (float*)d_out; p.ws = (unsigned char*)d_ws;
#if MK_N_LAUNCHES == 1
    p.ph_lo = 0; p.ph_hi = N_PHASES + 1;
    void* args[] = {&p};
    hipError_t e = hipLaunchCooperativeKernel((const void*)fwd_megakernel, dim3(grid), dim3(NTHR), args, LDS_BYTES, stream);
    if (e != hipSuccess) fprintf(stderr, "cooperative launch failed: %s (grid %d)\n", hipGetErrorString(e), grid);
#else
    for (int k = 0; k <= N_PHASES; ++k) { p.ph_lo = k; p.ph_hi = k + 1; hipLaunchKernelGGL(fwd_megakernel, dim3(grid), dim3(NTHR), LDS_BYTES, stream, p); }
#endif
}
```

```cpp
#include <hip/hip_runtime.h>
#include <hip/hip_cooperative_groups.h>
#include <cstdio>
#include <cstdint>
#include <cmath>
namespace cg = cooperative_groups;
namespace pg8 {
#define PG8_LAS __attribute__((address_space(3)))
typedef unsigned short bf16_t;
typedef short bf16x8 __attribute__((ext_vector_type(8)));
typedef float f32x4 __attribute__((ext_vector_type(4)));
typedef unsigned u32x4 __attribute__((ext_vector_type(4)));
constexpr int BM = 256, BK = 64, HALF = 128, HTB = HALF * BK * 2  , STAGE_BYTES = 8 * HTB, NXCD = 8, WGM = 8;

__host__ __device__ __forceinline__ int lds_byte(int r, int c) { const int st = (r >> 4) * 2 + (c >> 5), rr = r & 15, cc = c & 31, ob = rr * 64 + cc * 2; return st * 1024 + (ob ^ (((ob >> 9) & 1) << 5)); }
__host__ __device__ __forceinline__ void stage_rc(int b, int& R, int& C) { const int st = b / 1024, sb = b % 1024, swz = sb ^ (((sb >> 9) & 1) << 5); R = (st >> 1) * 16 + swz / 64; C = (st & 1) * 32 + (swz % 64) / 2; }
__host__ __device__ __forceinline__ int perm32(int rho) { const int n = rho >> 4, i = rho & 15; return 8 * (i >> 2) + 4 * n + (i & 3); }

struct Unit { int pm, pn; };
struct Gemm { const bf16_t* A; const bf16_t* Bt; int M, N, K; };

struct StaticOrder {
    int nM, nN, nwg, G, c;
    __host__ __device__ void init(int M, int N, int G_, int c_) { nM = M / BM; nN = N / BM; nwg = nM * nN; G = G_; c = c_; }
    __host__ __device__ bool next(int i, Unit& u) const {
        const long L = (long)i * G + c; if (L >= nwg) return false;
        int wgid = (int)L; { const int q = nwg / NXCD, r = nwg % NXCD, xcd = wgid % NXCD, off = wgid / NXCD; wgid = (xcd < r ? xcd * (q + 1) : r * (q + 1) + (xcd - r) * q) + off; }
        const int nig = WGM * nN, gid = wgid / nig, fm = gid * WGM, gsz = (nM - fm) < WGM ? (nM - fm) : WGM;
        u.pm = fm + ((wgid % nig) % gsz); u.pn = (wgid % nig) / gsz; return true;
    }
    __device__ __forceinline__ void a_ready(const Unit&) const {}
    __device__ __forceinline__ void done(const Unit&) const {}
};

__device__ __forceinline__ unsigned cvt_pk_bf16(float lo, float hi) { unsigned r; asm volatile("v_cvt_pk_bf16_f32 %0, %1, %2" : "=v"(r) : "v"(lo), "v"(hi)); return r; }
typedef float f32x2 __attribute__((ext_vector_type(2)));
template <class Epi, class Sched, bool ALIGN_EPI = false, bool SP2 = false>
__device__ __forceinline__ void gemm_phase(PG8_LAS unsigned char* lds, const Gemm g, const Sched& S, const Epi& E) {
    const int tid = threadIdx.x, wid = __builtin_amdgcn_readfirstlane(tid >> 6), lane = tid & 63, wr = wid >> 2, wc = wid & 3, fr = lane & 15, fq = lane >> 4;
    const int K = g.K, nt = K / BK;
    unsigned voffA[2], voffB[2];
#pragma unroll
    for (int i = 0; i < 2; ++i) { int R, C; stage_rc(tid * 16 + i * 8192, R, C); const int Rb = Epi::PERM ? ((R & ~31) + perm32(R & 31)) : R;
        voffA[i] = (unsigned)(R * K + C) * 2u; voffB[i] = (unsigned)(Rb * K + C) * 2u; }
    const size_t kstep = (size_t)(BK * 2);
    const size_t hstep = (size_t)HALF * K * 2;
    const size_t tstep = 2 * hstep;
    const unsigned ldsw = (unsigned)wid * 1024u;
    const int aoff = lds_byte(wr * 64 + fr, fq * 8), boff = lds_byte(wc * 32 + fr, fq * 8);
#define PG8_SA(b, h) (((b) * 2 + (h)) * HTB)
#define PG8_SB(b, h) ((4 + (b) * 2 + (h)) * HTB)
#define PG8_STAGE(bufoff, gbase, voff) do { _Pragma("unroll") for (int _i = 0; _i < 2; ++_i) \
        __builtin_amdgcn_global_load_lds((const unsigned*)((const char*)(gbase) + (voff)[_i]), (PG8_LAS unsigned*)(lds + (bufoff) + ldsw + _i * 8192), 16, 0, 0); } while (0)
#define PG8_LDA(dst, b, h) do { _Pragma("unroll") for (int m = 0; m < 4; ++m) _Pragma("unroll") for (int k = 0; k < 2; ++k) dst[m][k] = *(const PG8_LAS bf16x8*)(lds + PG8_SA(b, h) + aoff + m * 2048 + k * 1024); } while (0)
#define PG8_LDB(dst, b, h) do { _Pragma("unroll") for (int n = 0; n < 2; ++n) _Pragma("unroll") for (int k = 0; k < 2; ++k) dst[n][k] = *(const PG8_LAS bf16x8*)(lds + PG8_SB(b, h) + boff + n * 2048 + k * 1024); } while (0)
#define PG8_MMA(ai, bj, At, Bt) do { __builtin_amdgcn_s_setprio(1); _Pragma("unroll") for (int m = 0; m < 4; ++m) _Pragma("unroll") for (int n = 0; n < 2; ++n) _Pragma("unroll") for (int k = 0; k < 2; ++k) \
        acc[ai][bj][m][n] = __builtin_amdgcn_mfma_f32_16x16x32_bf16(Bt[n][k], At[m][k], acc[ai][bj][m][n], 0, 0, 0); __builtin_amdgcn_s_setprio(0); } while (0)
#define PG8_WAIT_V(n) asm volatile("s_waitcnt vmcnt(" #n ")" ::: "memory")
#define PG8_WAIT_L(n) asm volatile("s_waitcnt lgkmcnt(" #n ")" ::: "memory")
#define PG8_BAR __builtin_amdgcn_s_barrier()
#define PG8_SCHED __builtin_amdgcn_sched_barrier(0)
    Unit cur, nxt; int ui = 0;
    if (!S.next(0, cur)) return;
    f32x4 acc[2][2][4][2];
#pragma unroll
    for (int a = 0; a < 2; ++a)
#pragma unroll
        for (int b = 0; b < 2; ++b)
#pragma unroll
            for (int m = 0; m < 4; ++m)
#pragma unroll
                for (int n = 0; n < 2; ++n) acc[a][b][m][n] = (f32x4){0.f, 0.f, 0.f, 0.f};
    bf16x8 At[4][2], B0[2][2], B1[2][2];
    const char* cA = (const char*)g.A + (size_t)cur.pm * tstep; const char* cB = (const char*)g.Bt + (size_t)cur.pn * tstep;
    S.a_ready(cur);
    if constexpr (SP2) {
        PG8_STAGE(PG8_SB(0, 0), cB, voffB); PG8_STAGE(PG8_SB(0, 1), cB + hstep, voffB); PG8_STAGE(PG8_SA(0, 0), cA, voffA); PG8_STAGE(PG8_SA(0, 1), cA + hstep, voffA);
        if (wr == 1) PG8_BAR;
        PG8_WAIT_V(2); PG8_BAR;
        PG8_STAGE(PG8_SB(1, 0), cB + kstep, voffB); PG8_STAGE(PG8_SA(1, 0), cA + kstep, voffA); PG8_STAGE(PG8_SB(1, 1), cB + hstep + kstep, voffB);
        PG8_WAIT_V(6); PG8_BAR;
    } else {
        PG8_STAGE(PG8_SB(0, 0), cB, voffB); PG8_STAGE(PG8_SA(0, 0), cA, voffA); PG8_STAGE(PG8_SB(0, 1), cB + hstep, voffB); PG8_STAGE(PG8_SA(0, 1), cA + hstep, voffA);
        if (wr == 1) PG8_BAR;
        PG8_WAIT_V(4); PG8_BAR;
        PG8_STAGE(PG8_SB(1, 0), cB + kstep, voffB); PG8_STAGE(PG8_SA(1, 0), cA + kstep, voffA); PG8_STAGE(PG8_SB(1, 1), cB + hstep + kstep, voffB);
        PG8_WAIT_V(6); PG8_BAR;
    }
    for (;;) {
        const bool has_next = S.next(ui + 1, nxt);
        const char* nA = has_next ? (const char*)g.A + (size_t)nxt.pm * tstep : cA; const char* nB = has_next ? (const char*)g.Bt + (size_t)nxt.pn * tstep : cB;
        for (int t = 0; t < nt; t += 2) {
            const bool last = (t == nt - 2);
            const char* a1 = cA + (size_t)(t + 1) * kstep;
            const char* a2 = last ? nA : cA + (size_t)(t + 2) * kstep; const char* b2 = last ? nB : cB + (size_t)(t + 2) * kstep;
            const char* a3 = a2 + kstep; const char* b3 = b2 + kstep;
            if (last && has_next) S.a_ready(nxt);
            if constexpr (SP2) {
            PG8_LDB(B0, 0, 0); PG8_LDB(B1, 0, 1); PG8_SCHED; PG8_LDA(At, 0, 0); PG8_STAGE(PG8_SA(1, 1), a1 + hstep, voffA);
            PG8_WAIT_V(8); PG8_WAIT_L(0); PG8_BAR; PG8_MMA(0, 0, At, B0); PG8_MMA(0, 1, At, B1); PG8_BAR; PG8_SCHED;
            PG8_LDA(At, 0, 1); PG8_STAGE(PG8_SB(0, 0), b2, voffB); PG8_STAGE(PG8_SB(0, 1), b2 + hstep, voffB); PG8_STAGE(PG8_SA(0, 0), a2, voffA);
            PG8_WAIT_V(8); PG8_WAIT_L(0); PG8_BAR; PG8_MMA(1, 0, At, B0); PG8_MMA(1, 1, At, B1); PG8_BAR; PG8_SCHED;
            PG8_LDB(B0, 1, 0); PG8_LDB(B1, 1, 1); PG8_SCHED; PG8_LDA(At, 1, 0); PG8_STAGE(PG8_SA(0, 1), a2 + hstep, voffA);
            PG8_WAIT_V(8); PG8_WAIT_L(0); PG8_BAR; PG8_MMA(0, 0, At, B0); PG8_MMA(0, 1, At, B1); PG8_BAR; PG8_SCHED;
            PG8_LDA(At, 1, 1); PG8_STAGE(PG8_SB(1, 0), b3, voffB); PG8_STAGE(PG8_SB(1, 1), b3 + hstep, voffB); PG8_STAGE(PG8_SA(1, 0), a3, voffA);
            PG8_WAIT_V(8); PG8_WAIT_L(0); PG8_BAR; PG8_MMA(1, 0, At, B0); PG8_MMA(1, 1, At, B1); PG8_BAR; PG8_SCHED;
            } else {
            PG8_LDB(B0, 0, 0); PG8_SCHED; PG8_LDA(At, 0, 0); PG8_STAGE(PG8_SA(1, 1), a1 + hstep, voffA);
            PG8_WAIT_L(8); PG8_BAR; PG8_WAIT_L(0); PG8_MMA(0, 0, At, B0); PG8_BAR; PG8_SCHED;
            PG8_LDB(B1, 0, 1); PG8_STAGE(PG8_SB(0, 0), b2, voffB);
            PG8_BAR; PG8_WAIT_L(0); PG8_MMA(0, 1, At, B1); PG8_BAR;
            PG8_LDA(At, 0, 1); PG8_STAGE(PG8_SA(0, 0), a2, voffA);
            PG8_BAR; PG8_WAIT_L(0); PG8_MMA(1, 0, At, B0); PG8_BAR; PG8_SCHED;
            PG8_STAGE(PG8_SB(0, 1), b2 + hstep, voffB);
            PG8_WAIT_V(6); PG8_BAR; PG8_MMA(1, 1, At, B1); PG8_BAR;
            PG8_LDB(B0, 1, 0); PG8_SCHED; PG8_LDA(At, 1, 0); PG8_STAGE(PG8_SA(0, 1), a2 + hstep, voffA);
            PG8_WAIT_L(8); PG8_BAR; PG8_WAIT_L(0); PG8_MMA(0, 0, At, B0); PG8_BAR; PG8_SCHED;
            PG8_LDB(B1, 1, 1); PG8_STAGE(PG8_SB(1, 0), b3, voffB);
            PG8_BAR; PG8_WAIT_L(0); PG8_MMA(0, 1, At, B1); PG8_BAR;
            PG8_LDA(At, 1, 1); PG8_STAGE(PG8_SA(1, 0), a3, voffA);
            PG8_BAR; PG8_WAIT_L(0); PG8_MMA(1, 0, At, B0); PG8_BAR; PG8_SCHED;
            PG8_STAGE(PG8_SB(1, 1), b3 + hstep, voffB);
            PG8_WAIT_V(6); PG8_BAR; PG8_MMA(1, 1, At, B1); PG8_BAR;
            }
        }
        if constexpr (ALIGN_EPI) { if (wr == 0) PG8_BAR; }
        if constexpr (!Epi::AFTER_DRAIN) { E(acc, cur, wr, wc, fr, fq); S.done(cur); }
        if (!has_next) break;
#pragma unroll
        for (int a = 0; a < 2; ++a)
#pragma unroll
            for (int b = 0; b < 2; ++b)
#pragma unroll
                for (int m = 0; m < 4; ++m)
#pragma unroll
                    for (int n = 0; n < 2; ++n) acc[a][b][m][n] = (f32x4){0.f, 0.f, 0.f, 0.f};
        cur = nxt; cA = nA; cB = nB; ++ui;
        if constexpr (ALIGN_EPI) { if (wr == 1) PG8_BAR; }
    }
    PG8_WAIT_V(0);
    if constexpr (!ALIGN_EPI) { if (wr == 0) PG8_BAR; }
    PG8_BAR;
    if constexpr (Epi::AFTER_DRAIN) { E.fused(acc, cur, wr, wc, fr, fq, lds, wid, lane); S.done(cur); }
#undef PG8_SA
#undef PG8_SB
#undef PG8_STAGE
#undef PG8_LDA
#undef PG8_LDB
#undef PG8_MMA
#undef PG8_WAIT_V
#undef PG8_WAIT_L
#undef PG8_BAR
#undef PG8_SCHED
}
}

#ifndef REP_P0
#define REP_P0 1
#endif
#ifndef REP_P2
#define REP_P2 1
#endif
#ifndef REP_ATT
#define REP_ATT 1
#endif
#ifndef REP_GLA
#define REP_GLA 1
#endif
#ifndef REP_P5
#define REP_P5 1
#endif
#ifndef REP_P7
#define REP_P7 1
#endif
#ifndef REP_P8
#define REP_P8 1
#endif
#ifndef USE_CG_SYNC
#define USE_CG_SYNC 0
#endif
#ifndef MK_N_LAUNCHES
#define MK_N_LAUNCHES 1
#endif
#define LAS __attribute__((address_space(3)))
typedef unsigned short bf16;
typedef unsigned v4u __attribute__((ext_vector_type(4)));
typedef unsigned v2u __attribute__((ext_vector_type(2)));
typedef float f32x4 __attribute__((ext_vector_type(4)));
typedef short bf16x8 __attribute__((ext_vector_type(8)));
typedef short s16x4 __attribute__((ext_vector_type(4)));

constexpr int D = 1024, M = 16384, MP = 8192, NPROJ = 3104, NPP = 3328, FF = 4096;
constexpr int C_QA = 0, C_KA = 512, C_VA = 1024, C_QB = 1536, C_KB = 1792, C_VB = 2048, C_RB = 2560, C_GL = 3072;
constexpr float EPS = 1e-6f;
constexpr int NWAVES = 8, NTHR = 512;
constexpr int LDS_BYTES = 147456;

constexpr size_t MiB = 1u << 20;
constexpr size_t WS_WIN = 2 * MiB, WS_WOUT = 9 * MiB, WS_W1 = 11 * MiB, WS_W2 = 19 * MiB;
constexpr size_t WS_MOD = 27 * MiB, WS_ROPE = 27 * MiB + 240 * 1024, WS_CK = 28 * MiB, WS_CV = 30 * MiB;
constexpr size_t WS_XN = 32 * MiB, WS_PROJ = 64 * MiB, WS_GATE = 168 * MiB, WS_A2 = 170 * MiB, WS_OGF = 202 * MiB, WS_OGB = 218 * MiB;
constexpr size_t WS_MIX = 64 * MiB, WS_H = 64 * MiB, WS_F = 192 * MiB;
constexpr size_t O_Y = 0, O_NK = 16777216, O_NV = 20971520, O_SF = 25165824, O_SB = 26214400;

struct Params {
    const float *xp, *xs, *c, *cache_k, *cache_v, *state_f, *state_b, *c_ctx, *w_ada, *b_ada;
    const float *g_attn_pre, *g_attn_post, *g_mlp_pre, *g_mlp_post, *w_in, *wg_f, *bg_f, *wg_b, *bg_b;
    const float *lq1, *lk1, *lq2, *lk2, *diff_norm, *gla_norm, *w_out, *w_mlp1, *w_mlp2;
    float* out; unsigned char* ws;
    int ph_lo, ph_hi;
};

__device__ __forceinline__ unsigned f2bf(float f) { unsigned u = __builtin_bit_cast(unsigned, f); return (u + 0x7fffu + ((u >> 16) & 1u)) >> 16; }
__device__ __forceinline__ unsigned pk2(float lo, float hi) { return f2bf(lo) | (f2bf(hi) << 16); }
__device__ __forceinline__ float bf2f(unsigned short b) { return __builtin_bit_cast(float, (unsigned)b << 16); }
__device__ __forceinline__ float bflo(unsigned w) { return __builtin_bit_cast(float, w << 16); }
__device__ __forceinline__ float bfhi(unsigned w) { return __builtin_bit_cast(float, w & 0xffff0000u); }
__device__ __forceinline__ float wave_sum(float v) {
#pragma unroll
    for (int o = 1; o < 64; o <<= 1) v += __shfl_xor(v, o);
    return v;
}
__device__ __forceinline__ s16x4 trrd(const LAS unsigned char* p) { return __builtin_bit_cast(s16x4, __builtin_amdgcn_ds_read_tr16_b64_v4i16((LAS s16x4*)p)); }
__device__ __forceinline__ bf16x8 cat4(s16x4 lo, s16x4 hi) { return (bf16x8){lo[0], lo[1], lo[2], lo[3], hi[0], hi[1], hi[2], hi[3]}; }
__device__ __forceinline__ bf16x8 pack8(f32x4 a, f32x4 b) { v4u w; w.x = pk2(a[0], a[1]); w.y = pk2(a[2], a[3]); w.z = pk2(b[0], b[1]); w.w = pk2(b[2], b[3]); return __builtin_bit_cast(bf16x8, w); }
#define MFMA16(a, b, c) __builtin_amdgcn_mfma_f32_16x16x32_bf16((a), (b), (c), 0, 0, 0)

namespace pg8 {
struct EpiF32 {
    static constexpr bool PERM = true, AFTER_DRAIN = false;
    float* O; int ldc;
    __device__ __forceinline__ void operator()(const f32x4 (&acc)[2][2][4][2], const Unit& u, int wr, int wc, int fr, int fq) const {
#pragma unroll
        for (int ai = 0; ai < 2; ++ai)
#pragma unroll
            for (int m = 0; m < 4; ++m) { float* rp = O + (size_t)(u.pm * BM + ai * HALF + wr * 64 + m * 16 + fr) * ldc + u.pn * BM + wc * 32 + 8 * fq;
#pragma unroll
                for (int bj = 0; bj < 2; ++bj) { *(f32x4*)(rp + bj * HALF) = acc[ai][bj][m][0]; *(f32x4*)(rp + bj * HALF + 4) = acc[ai][bj][m][1]; } }
    }
};
struct EpiRelu2 {
    static constexpr bool PERM = true, AFTER_DRAIN = false;
    bf16_t* O; int ldc;
    __device__ __forceinline__ void operator()(const f32x4 (&acc)[2][2][4][2], const Unit& u, int wr, int wc, int fr, int fq) const {
#pragma unroll
        for (int ai = 0; ai < 2; ++ai)
#pragma unroll
            for (int m = 0; m < 4; ++m) { bf16_t* rp = O + (size_t)(u.pm * BM + ai * HALF + wr * 64 + m * 16 + fr) * ldc + u.pn * BM + wc * 32 + 8 * fq;
#pragma unroll
                for (int bj = 0; bj < 2; ++bj) { f32x4 a = acc[ai][bj][m][0], b = acc[ai][bj][m][1];
#pragma unroll
                    for (int j = 0; j < 4; ++j) { a[j] = a[j] > 0.f ? a[j] * a[j] : 0.f; b[j] = b[j] > 0.f ? b[j] * b[j] : 0.f; }
                    u32x4 w; w.x = cvt_pk_bf16(a[0], a[1]); w.y = cvt_pk_bf16(a[2], a[3]); w.z = cvt_pk_bf16(b[0], b[1]); w.w = cvt_pk_bf16(b[2], b[3]);
                    *(u32x4*)(rp + bj * HALF) = w; } }
    }
};
struct EpiInProj {
    static constexpr bool PERM = false, AFTER_DRAIN = false;
    bf16_t* P; float* GATE; float* newk; float* newv; const float* COS; const float* SIN;
    __device__ __forceinline__ void operator()(const f32x4 (&acc)[2][2][4][2], const Unit& u, int wr, int wc, int fr, int fq) const {
        typedef unsigned u32x2 __attribute__((ext_vector_type(2)));
        const int pn = u.pn;
#pragma unroll
        for (int ai = 0; ai < 2; ++ai)
#pragma unroll
            for (int m = 0; m < 4; ++m) {
                const int row = u.pm * BM + ai * HALF + wr * 64 + m * 16 + fr;
                const bool samp = row >= 8192;
                const int t = (row - 8192) & 1023;
#pragma unroll
                for (int bj = 0; bj < 2; ++bj) {
                    const int col0 = pn * BM + bj * HALF + wc * 32 + 4 * fq;
                    f32x4 v0 = acc[ai][bj][m][0], v1 = acc[ai][bj][m][1];
                    if (pn < 4 && samp) {
                        const int pos = ((col0 >> 5) & 1) ? (t & 63) : (t >> 6);
                        const f32x4 cs = *(const f32x4*)(COS + pos * 16 + 4 * fq), sn = *(const f32x4*)(SIN + pos * 16 + 4 * fq);
                        const f32x4 o0 = v0 * cs - v1 * sn, o1 = v0 * sn + v1 * cs; v0 = o0; v1 = o1;
                    }
                    if (pn == 12) {
                        if (bj == 0 && wc == 0) { *(f32x4*)(GATE + (size_t)row * 32 + 4 * fq) = v0; *(f32x4*)(GATE + (size_t)row * 32 + 16 + 4 * fq) = v1; }
                    } else {
                        bf16_t* pp = P + (size_t)row * 3328 + col0;
                        u32x2 w0, w1; w0.x = cvt_pk_bf16(v0[0], v0[1]); w0.y = cvt_pk_bf16(v0[2], v0[3]); w1.x = cvt_pk_bf16(v1[0], v1[1]); w1.y = cvt_pk_bf16(v1[2], v1[3]);
                        *(u32x2*)pp = w0; *(u32x2*)(pp + 16) = w1;
                        if (!samp && pn >= 2 && pn < 6) {
                            const int cc = (col0 - 512) & 511, hh = cc >> 7, dd = cc & 127;
                            float* op = (pn < 4 ? newk : newv) + ((size_t)((row >> 8) * 4 + hh) * 256 + (row & 255)) * 128 + dd;
                            *(f32x4*)op = v0; *(f32x4*)(op + 16) = v1;
                        }
                    }
                }
            }
    }
};
}

__device__ __forceinline__ void p0_transpose_item(const float* __restrict__ W, int K, int N, bf16* WT, LAS float* scr, int item, int lane) {
    const int nblk = N / 32, kb = item / nblk, nb = item % nblk, k0 = 64 * kb, n0 = 32 * nb;
#pragma unroll 8
    for (int i = 0; i < 32; ++i) { const int kk = 2 * i + (lane >> 5); scr[kk * 33 + (lane & 31)] = W[(size_t)(k0 + kk) * N + n0 + (lane & 31)]; }
    asm volatile("s_waitcnt lgkmcnt(0)" ::: "memory");
    const int c = lane & 7;
#pragma unroll
    for (int j = 0; j < 4; ++j) { const int n = (lane >> 3) + 8 * j; const LAS float* s = scr + (8 * c) * 33 + n;
        v4u o; o.x = pk2(s[0 * 33], s[1 * 33]); o.y = pk2(s[2 * 33], s[3 * 33]); o.z = pk2(s[4 * 33], s[5 * 33]); o.w = pk2(s[6 * 33], s[7 * 33]);
        *(v4u*)(WT + (size_t)(n0 + n) * K + k0 + 8 * c) = o; }
    asm volatile("s_waitcnt lgkmcnt(0)" ::: "memory");
}
__device__ __forceinline__ void sincos_tab(float ang, float& s, float& c) {
    const double x = (double)ang; const double k = rint(x * 0.15915494309189535);
    double r = fma(-k, 6.283185307179586, x); r = fma(-k, 2.4492935982947064e-16, r);
    const double r2 = r * r; double ts = 1.0, tc = 1.0, ss = 1.0, cc = 1.0;
#pragma unroll
    for (int n = 1; n <= 13; ++n) { tc *= -r2 * (1.0 / (double)((2 * n - 1) * (2 * n))); cc += tc; ts *= -r2 * (1.0 / (double)((2 * n) * (2 * n + 1))); ss += ts; }
    s = (float)(r * ss); c = (float)cc;
}
__device__ __forceinline__ void phase0(const Params& p, LAS unsigned char* lds) {
    const int tid = threadIdx.x, lane = tid & 63, wave = __builtin_amdgcn_readfirstlane(tid >> 6);
    unsigned char* ws = p.ws;
    float* MOD = (float*)(ws + WS_MOD);
    {
        LAS float* Ssil = (LAS float*)lds; LAS float* part = (LAS float*)(lds + 36864);
        bool have = false;
        for (int j = blockIdx.x; j < 96; j += gridDim.x) {
            if (!have) {
                for (int i = tid; i < 9 * 1024; i += NTHR) { const int r = i >> 10, k = i & 1023; const float v = (r == 0) ? p.c_ctx[k] : p.c[(r - 1) * 1024 + k]; Ssil[i] = v / (1.f + __expf(-v)); }
                __syncthreads(); have = true;
            }
            float a0 = 0.f, a1 = 0.f, a2 = 0.f, a3 = 0.f, a4 = 0.f, a5 = 0.f, a6 = 0.f, a7 = 0.f, a8 = 0.f;
            const int col = 64 * j + lane, k0 = wave * 128;
            const float* wp = p.w_ada + (size_t)k0 * 6144 + col;
#pragma unroll 8
            for (int kk = 0; kk < 128; ++kk) {
                const float w = wp[(size_t)kk * 6144]; const LAS float* sp = Ssil + k0 + kk;
                a0 += sp[0] * w; a1 += sp[1024] * w; a2 += sp[2048] * w; a3 += sp[3072] * w; a4 += sp[4096] * w; a5 += sp[5120] * w; a6 += sp[6144] * w; a7 += sp[7168] * w; a8 += sp[8192] * w;
            }
            LAS float* pp = part + wave * 576 + lane;
            pp[0] = a0; pp[64] = a1; pp[128] = a2; pp[192] = a3; pp[256] = a4; pp[320] = a5; pp[384] = a6; pp[448] = a7; pp[512] = a8;
            __syncthreads();
            for (int i = tid; i < 576; i += NTHR) { const int r = i >> 6, ci = i & 63; float s = p.b_ada[64 * j + ci];
#pragma unroll
                for (int w = 0; w < 8; ++w) s += part[w * 576 + i];
                MOD[r * 6144 + 64 * j + ci] = s; }
            __syncthreads();
        }
        __syncthreads();
    }
    if (blockIdx.x == gridDim.x - 1) {
        float* COS = (float*)(ws + WS_ROPE); float* SIN = COS + 1024;
        for (int i = tid; i < 1024; i += NTHR) { const int pos = i >> 4, fi = i & 15; const float inv = exp2f(-(float)fi * (13.287712379549449f / 16.f));
            float s, c; sincos_tab((float)pos * inv, s, c); COS[i] = c; SIN[i] = s; }
    }
    {
        LAS float* scr = (LAS float*)(lds + wave * 16384);
        const int gw = blockIdx.x * NWAVES + wave, NGW = gridDim.x * NWAVES;
        constexpr int I_IN = 16 * 97, I_O = 16 * 32, I_1 = 16 * 128, I_2 = 64 * 32, NIT = I_IN + I_O + I_1 + I_2;
        for (int it = gw; it < NIT; it += NGW) {
            int r = it;
            if (r < I_IN) { p0_transpose_item(p.w_in, 1024, NPROJ, (bf16*)(ws + WS_WIN), scr, r, lane); continue; } r -= I_IN;
            if (r < I_O) { p0_transpose_item(p.w_out, 1024, 1024, (bf16*)(ws + WS_WOUT), scr, r, lane); continue; } r -= I_O;
            if (r < I_1) { p0_transpose_item(p.w_mlp1, 1024, 4096, (bf16*)(ws + WS_W1), scr, r, lane); continue; } r -= I_1;
            p0_transpose_item(p.w_mlp2, 4096, 1024, (bf16*)(ws + WS_W2), scr, r, lane);
        }
    }
    {
        const int gt = blockIdx.x * NTHR + tid, NGT = gridDim.x * NTHR;
        v4u* zp = (v4u*)(ws + WS_WIN + (size_t)NPROJ * 1024 * 2);
        for (int i = gt; i < (NPP - NPROJ) * 1024 * 2 / 16; i += NGT) zp[i] = (v4u){0u, 0u, 0u, 0u};
        const f32x4* ck = (const f32x4*)p.cache_k; const f32x4* cv = (const f32x4*)p.cache_v;
        v2u* ok = (v2u*)(ws + WS_CK); v2u* ov = (v2u*)(ws + WS_CV);
        for (int i = gt; i < 262144; i += NGT) { const f32x4 a = ck[i], b = cv[i]; v2u x, y; x.x = pk2(a[0], a[1]); x.y = pk2(a[2], a[3]); y.x = pk2(b[0], b[1]); y.y = pk2(b[2], b[3]); ok[i] = x; ov[i] = y; }
    }
}

__device__ __forceinline__ void phase1(const Params& p) {
    const int tid = threadIdx.x, lane = tid & 63, wave = tid >> 6;
    const float* MOD = (const float*)(p.ws + WS_MOD); bf16* XN = (bf16*)(p.ws + WS_XN);
    const int gw = blockIdx.x * NWAVES + wave, NGW = gridDim.x * NWAVES;
    for (int row = gw; row < M; row += NGW) {
        const float* xr = row < MP ? p.xp + (size_t)row * D : p.xs + (size_t)(row - MP) * D;
        const int r = row < MP ? 0 : 1 + ((row - MP) >> 10);
        f32x4 v[4]; float s2 = 0.f;
#pragma unroll
        for (int j = 0; j < 4; ++j) { v[j] = ((const f32x4*)xr)[lane + 64 * j]; s2 += (v[j][0] * v[j][0] + v[j][1] * v[j][1]) + (v[j][2] * v[j][2] + v[j][3] * v[j][3]); }
        const float rstd = 1.0f / sqrtf(wave_sum(s2) * (1.f / D) + EPS);
        const float* mr = MOD + r * 6144;
#pragma unroll
        for (int j = 0; j < 4; ++j) { const int q = lane + 64 * j;
            const f32x4 g = ((const f32x4*)p.g_attn_pre)[q], sh = ((const f32x4*)mr)[q], sc = ((const f32x4*)(mr + 1024))[q];
            const f32x4 h = (v[j] * rstd * g) * (sc + 1.0f) + sh;
            v2u w; w.x = pk2(h[0], h[1]); w.y = pk2(h[2], h[3]); ((v2u*)(XN + (size_t)row * D))[q] = w; }
    }
}

constexpr int KP = 272, VP = 288, KT_BYTES = 64 * KP, VT_BYTES = 64 * VP, ABUF = KT_BYTES + VT_BYTES;
constexpr float CS = 0.125f * 1.4426950408889634f;

__device__ __forceinline__ void att_load(const Params& p, int samp, int b, int h, int t, int tid, v4u (&kr)[2], v4u (&vr)[2]) {
    const bf16* PROJ = (const bf16*)(p.ws + WS_PROJ);
#pragma unroll
    for (int i = 0; i < 2; ++i) {
        const int id = tid + 512 * i, r = id >> 4, ch = id & 15;
        const bf16 *kp, *vp;
        if (samp && t < 4) { const size_t o = ((size_t)(b * 4 + h) * 256 + t * 64 + r) * 128 + ch * 8; kp = (const bf16*)(p.ws + WS_CK) + o; vp = (const bf16*)(p.ws + WS_CV) + o; }
        else { const int row = samp ? (MP + b * 1024 + (t - 4) * 64 + r) : (b * 256 + t * 64 + r); const bf16* rp = PROJ + (size_t)row * NPP + h * 128 + ch * 8; kp = rp + C_KA; vp = rp + C_VA; }
        kr[i] = *(const v4u*)kp; vr[i] = *(const v4u*)vp;
    }
}
__device__ __forceinline__ void att_store(LAS unsigned char* buf, int tid, const v4u (&kr)[2], const v4u (&vr)[2]) {
#pragma unroll
    for (int i = 0; i < 2; ++i) { const int id = tid + 512 * i, r = id >> 4, ch = id & 15;
        *(LAS v4u*)(buf + r * KP + ch * 16) = kr[i]; *(LAS v4u*)(buf + KT_BYTES + r * VP + ch * 16) = vr[i]; }
}
__device__ __forceinline__ void softmax_step(f32x4 (&S)[4], float& m, float& l, f32x4 (&O)[8]) {
    float mx = S[0][0];
#pragma unroll
    for (int kb = 0; kb < 4; ++kb)
#pragma unroll
        for (int r = 0; r < 4; ++r) mx = fmaxf(mx, S[kb][r]);
    mx = fmaxf(mx, __shfl_xor(mx, 16)); mx = fmaxf(mx, __shfl_xor(mx, 32));
    const float mnew = fmaxf(m, mx * CS), alpha = __builtin_amdgcn_exp2f(m - mnew); m = mnew;
    float ps = 0.f;
#pragma unroll
    for (int kb = 0; kb < 4; ++kb)
#pragma unroll
        for (int r = 0; r < 4; ++r) { const float pv = __builtin_amdgcn_exp2f(S[kb][r] * CS - mnew); S[kb][r] = pv; ps += pv; }
    l = l * alpha + ps;
#pragma unroll
    for (int c = 0; c < 8; ++c) O[c] = O[c] * alpha;
}
__device__ __forceinline__ void attn_unit(const Params& p, LAS unsigned char* lds, int samp, int b, int h, int qb, float lam) {
    const int tid = threadIdx.x, lane = tid & 63, wave = __builtin_amdgcn_readfirstlane(tid >> 6), g = lane >> 4, fr = lane & 15;
    const bf16* PROJ = (const bf16*)(p.ws + WS_PROJ);
    const int rowbase = samp ? MP + b * 1024 : b * 256, NT = samp ? 20 : 4;
    const int qrow = rowbase + qb * 128 + wave * 16 + fr;
    bf16x8 Qf[4];
#pragma unroll
    for (int ds = 0; ds < 4; ++ds) Qf[ds] = *(const bf16x8*)(PROJ + (size_t)qrow * NPP + C_QA + h * 128 + 32 * ds + 8 * g);
    f32x4 O1[8], O2[8];
#pragma unroll
    for (int c = 0; c < 8; ++c) { O1[c] = (f32x4){0.f, 0.f, 0.f, 0.f}; O2[c] = (f32x4){0.f, 0.f, 0.f, 0.f}; }
    float m1 = -INFINITY, m2 = -INFINITY, l1 = 0.f, l2 = 0.f;
    v4u kr[2], vr[2];
    att_load(p, samp, b, h, 0, tid, kr, vr);
    att_store(lds, tid, kr, vr);
    __syncthreads();
    for (int t = 0; t < NT; ++t) {
        const LAS unsigned char* Kb = lds + (t & 1) * ABUF; const LAS unsigned char* Vb = Kb + KT_BYTES;
        if (t + 1 < NT) att_load(p, samp, b, h, t + 1, tid, kr, vr);
        f32x4 S1[4], S2[4];
#pragma unroll
        for (int kb = 0; kb < 4; ++kb) {
            const LAS unsigned char* kp = Kb + (16 * kb + fr) * KP + 16 * g;
            const bf16x8 k0 = *(const LAS bf16x8*)kp, k1 = *(const LAS bf16x8*)(kp + 64), k2 = *(const LAS bf16x8*)(kp + 128), k3 = *(const LAS bf16x8*)(kp + 192);
            f32x4 z = (f32x4){0.f, 0.f, 0.f, 0.f};
            S1[kb] = MFMA16(k0, Qf[0], z); S1[kb] = MFMA16(k1, Qf[1], S1[kb]);
            S2[kb] = MFMA16(k2, Qf[2], z); S2[kb] = MFMA16(k3, Qf[3], S2[kb]);
        }
        softmax_step(S1, m1, l1, O1);
        softmax_step(S2, m2, l2, O2);
        bf16x8 P1[2], P2[2];
#pragma unroll
        for (int kk = 0; kk < 2; ++kk) { P1[kk] = pack8(S1[2 * kk], S1[2 * kk + 1]); P2[kk] = pack8(S2[2 * kk], S2[2 * kk + 1]); }
        const LAS unsigned char* vb = Vb + (4 * g + (fr >> 2)) * VP + 8 * (fr & 3);
#pragma unroll
        for (int kk = 0; kk < 2; ++kk)
#pragma unroll
            for (int c = 0; c < 8; ++c) {
                const s16x4 lo = trrd(vb + kk * 32 * VP + c * 32), hi = trrd(vb + kk * 32 * VP + 16 * VP + c * 32);
                const bf16x8 vf = cat4(lo, hi);
                O1[c] = MFMA16(vf, P1[kk], O1[c]); O2[c] = MFMA16(vf, P2[kk], O2[c]);
            }
        if (t + 1 < NT) att_store(lds + ((t + 1) & 1) * ABUF, tid, kr, vr);
        __syncthreads();
    }
    l1 += __shfl_xor(l1, 16); l1 += __shfl_xor(l1, 32); l2 += __shfl_xor(l2, 16); l2 += __shfl_xor(l2, 32);
    const float i1 = 1.0f / l1, i2 = lam / l2; float ss = 0.f;
#pragma unroll
    for (int c = 0; c < 8; ++c) { O1[c] = O1[c] * i1 - O2[c] * i2; ss += (O1[c][0] * O1[c][0] + O1[c][1] * O1[c][1]) + (O1[c][2] * O1[c][2] + O1[c][3] * O1[c][3]); }
    ss += __shfl_xor(ss, 16); ss += __shfl_xor(ss, 32);
    const float rstd = (1.0f / sqrtf(ss * (1.f / 128.f) + EPS)) * 0.8f;
    bf16* A2 = (bf16*)(p.ws + WS_A2) + (size_t)qrow * D + h * 128 + 4 * g;
#pragma unroll
    for (int c = 0; c < 8; ++c) { const f32x4 dn = *(const f32x4*)(p.diff_norm + 16 * c + 4 * g); const f32x4 o = O1[c] * rstd * dn;
        v2u w; w.x = pk2(o[0], o[1]); w.y = pk2(o[2], o[3]); *(v2u*)(A2 + 16 * c) = w; }
}

constexpr int QP = 144, VP2 = 288;
constexpr int GI_QT = 0, GI_KT = 64 * QP, GI_VT = 2 * 64 * QP, GI_WG = GI_VT + 64 * VP2, GI_BG = GI_WG + 4096;
constexpr size_t WS_BL = 27 * MiB + 256 * 1024, WS_VT = WS_XN;
__device__ __forceinline__ float logsig(float x) { return fminf(x, 0.f) - __logf(1.f + __expf(-fabsf(x))); }
__device__ __forceinline__ void gla_decode(int item, int& samp, int& b, int& h, int& dir, int& ch) {
    if (item < 1024) { samp = 1; ch = item & 15; dir = (item >> 4) & 1; h = (item >> 5) & 3; b = item >> 7; }
    else { const int i = item - 1024; samp = 0; ch = i & 3; dir = (i >> 2) & 1; h = (i >> 3) & 3; b = i >> 5; }
}
__device__ __forceinline__ void gla_intra(const Params& p, LAS unsigned char* lds, int item) {
    const int tid = threadIdx.x, lane = tid & 63, wave = __builtin_amdgcn_readfirstlane(tid >> 6), g = lane >> 4, fr = lane & 15;
    int samp, b, h, dir, ch; gla_decode(item, samp, b, h, dir, ch);
    const bf16* PROJ = (const bf16*)(p.ws + WS_PROJ); const float* GATE = (const float*)(p.ws + WS_GATE);
    bf16* OG = (bf16*)(p.ws + (dir ? WS_OGB : WS_OGF));
    bf16* QT = (bf16*)p.out + (size_t)item * 4096; bf16* KH = (bf16*)p.out + (size_t)8388608 + (size_t)item * 4096;
    bf16* VT = (bf16*)(p.ws + WS_VT) + (size_t)item * 8192; float* BLg = (float*)(p.ws + WS_BL) + item * 64;
    const int L = samp ? 1024 : 256, rowbase = samp ? MP + b * 1024 : b * 256;
    LAS float* WgL = (LAS float*)(lds + GI_WG); LAS float* BgL = (LAS float*)(lds + GI_BG);
    {
        const float* wg = dir ? p.wg_b : p.wg_f; const float* bg = dir ? p.bg_b : p.bg_f;
        for (int i = tid; i < 1024; i += NTHR) WgL[i] = wg[(i >> 6) * 256 + h * 64 + (i & 63)];
        if (tid < 64) BgL[tid] = bg[h * 64 + tid];
    }
    const int tpos0 = ch * 64 + lane, tok0 = dir ? (L - 1 - tpos0) : tpos0, row0 = rowbase + tok0;
    const float* gp = GATE + (size_t)row0 * 32 + dir * 16;
    const f32x4 g0 = *(const f32x4*)gp, g1 = *(const f32x4*)(gp + 4), g2 = *(const f32x4*)(gp + 8), g3 = *(const f32x4*)(gp + 12);
    const bf16* rp = PROJ + (size_t)row0 * NPP;
    const v4u qw = *(const v4u*)(rp + C_QB + h * 64 + 8 * wave), kw = *(const v4u*)(rp + C_KB + h * 64 + 8 * wave);
    const v4u vw0 = *(const v4u*)(rp + C_VB + h * 128 + 8 * wave), vw1 = *(const v4u*)(rp + C_VB + h * 128 + 64 + 8 * wave);
    __syncthreads();
    {
        float gl[16] = {g0[0], g0[1], g0[2], g0[3], g1[0], g1[1], g1[2], g1[3], g2[0], g2[1], g2[2], g2[3], g3[0], g3[1], g3[2], g3[3]};
        float x[8];
#pragma unroll
        for (int e = 0; e < 8; ++e) x[e] = BgL[8 * wave + e];
#pragma unroll
        for (int j = 0; j < 16; ++j) { const f32x4 wa = *(const LAS f32x4*)(WgL + j * 64 + 8 * wave), wb = *(const LAS f32x4*)(WgL + j * 64 + 8 * wave + 4);
#pragma unroll
            for (int e = 0; e < 4; ++e) { x[e] += gl[j] * wa[e]; x[4 + e] += gl[j] * wb[e]; } }
        float qf[8], kf[8];
#pragma unroll
        for (int e = 0; e < 4; ++e) { const unsigned a = qw[e], bb = kw[e]; qf[2 * e] = bflo(a); qf[2 * e + 1] = bfhi(a); kf[2 * e] = bflo(bb); kf[2 * e + 1] = bfhi(bb); }
        float qt[8], kt[8];
#pragma unroll
        for (int e = 0; e < 8; ++e) {
            float v = logsig(x[e]) * (1.f / 16.f);
#pragma unroll
            for (int o = 1; o < 64; o <<= 1) { const float u = __shfl_up(v, o); if (lane >= o) v += u; }
            const float blast = __shfl(v, 63);
            qt[e] = qf[e] * 0.125f * __expf(v); kt[e] = kf[e] * __expf(-v);
            KH[(8 * wave + e) * 64 + lane] = (bf16)f2bf(kf[e] * __expf(blast - v));
            if (lane == 63) BLg[8 * wave + e] = __expf(blast);
        }
        v4u w;
        w.x = pk2(qt[0], qt[1]); w.y = pk2(qt[2], qt[3]); w.z = pk2(qt[4], qt[5]); w.w = pk2(qt[6], qt[7]);
        *(LAS v4u*)(lds + GI_QT + lane * QP + 16 * wave) = w; *(v4u*)(QT + lane * 64 + 8 * wave) = w;
        w.x = pk2(kt[0], kt[1]); w.y = pk2(kt[2], kt[3]); w.z = pk2(kt[4], kt[5]); w.w = pk2(kt[6], kt[7]); *(LAS v4u*)(lds + GI_KT + lane * QP + 16 * wave) = w;
        *(LAS v4u*)(lds + GI_VT + lane * VP2 + 16 * wave) = vw0; *(LAS v4u*)(lds + GI_VT + lane * VP2 + 128 + 16 * wave) = vw1;
#pragma unroll
        for (int e = 0; e < 4; ++e) {
            VT[(8 * wave + 2 * e) * 64 + lane] = (bf16)(vw0[e] & 0xffffu); VT[(8 * wave + 2 * e + 1) * 64 + lane] = (bf16)(vw0[e] >> 16);
            VT[(64 + 8 * wave + 2 * e) * 64 + lane] = (bf16)(vw1[e] & 0xffffu); VT[(64 + 8 * wave + 2 * e + 1) * 64 + lane] = (bf16)(vw1[e] >> 16);
        }
    }
    __syncthreads();
    {
        const int a = wave >> 1, half = wave & 1;
        f32x4 at[4];
#pragma unroll
        for (int sb = 0; sb < 4; ++sb) {
            at[sb] = (f32x4){0.f, 0.f, 0.f, 0.f};
            if (sb <= a) {
#pragma unroll
                for (int ks = 0; ks < 2; ++ks) { const bf16x8 kfr = *(const LAS bf16x8*)(lds + GI_KT + (16 * sb + fr) * QP + 64 * ks + 16 * g);
                    const bf16x8 qfr = *(const LAS bf16x8*)(lds + GI_QT + (16 * a + fr) * QP + 64 * ks + 16 * g);
                    at[sb] = MFMA16(kfr, qfr, at[sb]); }
                if (sb == a) {
#pragma unroll
                    for (int r = 0; r < 4; ++r) if (4 * g + r > fr) at[sb][r] = 0.f; }
            }
        }
        const bf16x8 pa0 = pack8(at[0], at[1]), pa1 = pack8(at[2], at[3]);
#pragma unroll
        for (int cc = 0; cc < 4; ++cc) {
            const int c = 4 * half + cc;
            const LAS unsigned char* vtb = lds + GI_VT + 32 * c + 8 * (fr & 3) + (4 * g + (fr >> 2)) * VP2;
            f32x4 o = (f32x4){0.f, 0.f, 0.f, 0.f};
            { const s16x4 lo = trrd(vtb), hi = trrd(vtb + 16 * VP2); o = MFMA16(pa0, cat4(lo, hi), o); }
            if (a >= 2) { const s16x4 lo = trrd(vtb + 32 * VP2), hi = trrd(vtb + 48 * VP2); o = MFMA16(pa1, cat4(lo, hi), o); }
#pragma unroll
            for (int r = 0; r < 4; ++r) { const int tpos = ch * 64 + 16 * a + 4 * g + r, tok = dir ? (L - 1 - tpos) : tpos;
                OG[(size_t)(rowbase + tok) * 512 + h * 128 + 16 * c + fr] = (bf16)f2bf(o[r]); }
        }
    }
    __syncthreads();
}

struct GbRegs { v4u q, k; f32x4 bl; v4u vt0, vt1; };
constexpr int GB_SLOT = 2 * 64 * QP + 256;
__device__ __forceinline__ void gb_ld(const Params& p, GbRegs& R, int item, int c, int g, int fr, int tid) {
    const bf16* QT = (const bf16*)p.out + (size_t)item * 4096; const bf16* KH = (const bf16*)p.out + (size_t)8388608 + (size_t)item * 4096;
    const bf16* VT = (const bf16*)(p.ws + WS_VT) + (size_t)item * 8192; const float* BLg = (const float*)(p.ws + WS_BL) + item * 64;
    R.q = *(const v4u*)(QT + tid * 8); R.k = *(const v4u*)(KH + tid * 8); R.bl = *(const f32x4*)(BLg + (tid & 15) * 4);
    R.vt0 = *(const v4u*)(VT + (16 * c + fr) * 64 + 8 * g); R.vt1 = *(const v4u*)(VT + (16 * c + fr) * 64 + 32 + 8 * g);
}
__device__ __forceinline__ void gb_st(LAS unsigned char* slot, const GbRegs& R, int tid) {
    *(LAS v4u*)(slot + (tid >> 3) * QP + (tid & 7) * 16) = R.q; *(LAS v4u*)(slot + 64 * QP + (tid >> 3) * QP + (tid & 7) * 16) = R.k;
    if (tid < 16) *(LAS f32x4*)(slot + 2 * 64 * QP + tid * 16) = R.bl;
}
__device__ __forceinline__ void gb_step(const LAS unsigned char* slot, f32x4 (&S)[4], const v4u vt0, const v4u vt1, bf16* ogb, int oidx, int tstep, int g, int fr) {
    const bf16x8 sb0 = pack8(S[0], S[1]), sb1 = pack8(S[2], S[3]);
#pragma unroll
    for (int a = 0; a < 4; ++a) {
        const LAS unsigned char* qp = slot + (16 * a + fr) * QP + 8 * g;
        const v2u l0 = *(const LAS v2u*)qp, h0 = *(const LAS v2u*)(qp + 32), l1 = *(const LAS v2u*)(qp + 64), h1 = *(const LAS v2u*)(qp + 96);
        f32x4 o = (f32x4){0.f, 0.f, 0.f, 0.f};
        { const v4u aw = (v4u){l0.x, l0.y, h0.x, h0.y}; o = MFMA16(__builtin_bit_cast(bf16x8, aw), sb0, o); }
        { const v4u aw = (v4u){l1.x, l1.y, h1.x, h1.y}; o = MFMA16(__builtin_bit_cast(bf16x8, aw), sb1, o); }
#pragma unroll
        for (int r = 0; r < 4; ++r) ogb[oidx + (16 * a + r) * tstep] = (bf16)f2bf(o[r]);
    }
#pragma unroll
    for (int kb = 0; kb < 4; ++kb) {
        const f32x4 bl = *(const LAS f32x4*)(slot + 2 * 64 * QP + (16 * kb + 4 * g) * 4);
        const LAS unsigned char* kp = slot + 64 * QP + (16 * kb + fr) * QP + 16 * g;
        const bf16x8 k0 = *(const LAS bf16x8*)kp, k1 = *(const LAS bf16x8*)(kp + 64);
        S[kb] = S[kb] * bl;
        S[kb] = MFMA16(k0, __builtin_bit_cast(bf16x8, vt0), S[kb]);
        S[kb] = MFMA16(k1, __builtin_bit_cast(bf16x8, vt1), S[kb]);
    }
}
__device__ __forceinline__ void gla_chain(const Params& p, LAS unsigned char* lds, int samp, int b, int h, int dir) {
    const int tid = threadIdx.x, lane = tid & 63, g = lane >> 4, fr = lane & 15, c = __builtin_amdgcn_readfirstlane(tid >> 6);
    const int L = samp ? 1024 : 256, NC = L / 64, rowbase = samp ? MP + b * 1024 : b * 256;
    const int item0 = samp ? (((b * 4 + h) * 2 + dir) * 16) : (1024 + ((b * 4 + h) * 2 + dir) * 4);
    bf16* ogb = (bf16*)p.out + (size_t)(dir ? 25165824 : 16777216);
    const int tstep = dir ? -512 : 512;
    f32x4 S[4];
    if (samp) { const float* st = (dir ? p.state_b : p.state_f) + (size_t)(b * 4 + h) * 64 * 128 + 16 * c + fr;
#pragma unroll
        for (int kb = 0; kb < 4; ++kb)
#pragma unroll
            for (int r = 0; r < 4; ++r) S[kb][r] = st[(16 * kb + 4 * g + r) * 128]; }
    else {
#pragma unroll
        for (int kb = 0; kb < 4; ++kb) S[kb] = (f32x4){0.f, 0.f, 0.f, 0.f}; }
    int oidx = (rowbase + (dir ? (L - 1) : 0)) * 512 + 4 * g * tstep + h * 128 + 16 * c + fr;
    GbRegs R0, R1;
    gb_ld(p, R0, item0, c, g, fr, tid); gb_ld(p, R1, item0 + 1, c, g, fr, tid);
    for (int ch = 0; ch < NC; ch += 2) {
        { gb_st(lds, R0, tid); __syncthreads(); const v4u a0 = R0.vt0, a1 = R0.vt1;
          if (ch + 2 < NC) gb_ld(p, R0, item0 + ch + 2, c, g, fr, tid);
          gb_step(lds, S, a0, a1, ogb, oidx, tstep, g, fr); oidx += 64 * tstep; }
        { gb_st(lds + GB_SLOT, R1, tid); __syncthreads(); const v4u a0 = R1.vt0, a1 = R1.vt1;
          if (ch + 3 < NC) gb_ld(p, R1, item0 + ch + 3, c, g, fr, tid);
          gb_step(lds + GB_SLOT, S, a0, a1, ogb, oidx, tstep, g, fr); oidx += 64 * tstep; }
    }
    __syncthreads();
    if (!samp) {
        float* so = p.out + (dir ? O_SB : O_SF) + (size_t)(b * 4 + h) * 64 * 128 + 16 * c + fr;
#pragma unroll
        for (int kb = 0; kb < 4; ++kb)
#pragma unroll
            for (int r = 0; r < 4; ++r) so[(16 * kb + 4 * g + r) * 128] = S[kb][r];
    }
}
__device__ __forceinline__ void phase_gla_inter(const Params& p, LAS unsigned char* lds) {
    for (int rep = 0; rep < REP_GLA; ++rep) {
        if (gridDim.x == 256) {
            const int u = blockIdx.x;
            if (u < 64) gla_chain(p, lds, 1, u >> 3, (u >> 1) & 3, u & 1);
            else { for (int v = u - 64; v < 256; v += 192) gla_chain(p, lds, 0, v >> 3, (v >> 1) & 3, v & 1); }
        } else {
            for (int u = blockIdx.x; u < 320; u += gridDim.x) { if (u < 64) gla_chain(p, lds, 1, u >> 3, (u >> 1) & 3, u & 1); else { const int v = u - 64; gla_chain(p, lds, 0, v >> 3, (v >> 1) & 3, v & 1); } }
        }
    }
}

__device__ __forceinline__ void phase3(const Params& p, LAS unsigned char* lds) {
    const int lane = threadIdx.x & 63;
    float lam;
    { const float a = wave_sum(p.lq1[lane] * p.lk1[lane]), b = wave_sum(p.lq2[lane] * p.lk2[lane]); lam = __expf(a) - __expf(b) + 0.2f; }
    for (int it = blockIdx.x; it < 2048; it += gridDim.x) gla_intra(p, lds, it);
    for (int rep = 0; rep < REP_ATT; ++rep) {
    for (int u = blockIdx.x; u < 256; u += gridDim.x) attn_unit(p, lds, 0, u >> 3, (u >> 1) & 3, u & 1, lam);
    for (int u = blockIdx.x; u < 256; u += gridDim.x) attn_unit(p, lds, 1, u >> 5, (u >> 3) & 3, u & 7, lam);
    }
}


__device__ __forceinline__ void phase3b(const Params& p) {
    const int tid = threadIdx.x, lane = tid & 63, wave = tid >> 6;
    const bf16* PROJ = (const bf16*)(p.ws + WS_PROJ); const bf16* OGF = (const bf16*)(p.ws + WS_OGF); const bf16* OGB = (const bf16*)(p.ws + WS_OGB);
    bf16* A2 = (bf16*)(p.ws + WS_A2);
    const int gw = blockIdx.x * NWAVES + wave, NGW = gridDim.x * NWAVES;
    const f32x4 n0 = *(const f32x4*)(p.gla_norm + 8 * (lane & 15)), n1 = *(const f32x4*)(p.gla_norm + 8 * (lane & 15) + 4);
    for (int row = gw; row < M; row += NGW) {
        const v4u a = *(const v4u*)(OGF + (size_t)row * 512 + 8 * lane), bq = *(const v4u*)(OGB + (size_t)row * 512 + 8 * lane);
        const v4u a2 = *(const v4u*)((const bf16*)p.out + (size_t)16777216 + (size_t)row * 512 + 8 * lane), b2 = *(const v4u*)((const bf16*)p.out + (size_t)25165824 + (size_t)row * 512 + 8 * lane);
        const v4u rw = *(const v4u*)(PROJ + (size_t)row * NPP + C_RB + 8 * lane);
        float o[8], rr[8]; float ss = 0.f;
#pragma unroll
        for (int e = 0; e < 4; ++e) { o[2 * e] = (bflo(a[e]) + bflo(bq[e])) + (bflo(a2[e]) + bflo(b2[e])); o[2 * e + 1] = (bfhi(a[e]) + bfhi(bq[e])) + (bfhi(a2[e]) + bfhi(b2[e])); rr[2 * e] = bflo(rw[e]); rr[2 * e + 1] = bfhi(rw[e]); }
#pragma unroll
        for (int e = 0; e < 8; ++e) ss += o[e] * o[e];
        ss += __shfl_xor(ss, 1); ss += __shfl_xor(ss, 2); ss += __shfl_xor(ss, 4); ss += __shfl_xor(ss, 8);
        const float rstd = 1.0f / sqrtf(ss * (1.f / 128.f) + EPS);
        float y[8];
#pragma unroll
        for (int e = 0; e < 8; ++e) { const float nw = e < 4 ? n0[e] : n1[e - 4]; const float sl = rr[e] / (1.f + __expf(-rr[e])); y[e] = o[e] * rstd * nw * sl; }
        v4u w; w.x = pk2(y[0], y[1]); w.y = pk2(y[2], y[3]); w.z = pk2(y[4], y[5]); w.w = pk2(y[6], y[7]);
        *(v4u*)(A2 + (size_t)row * D + 512 + 8 * lane) = w;
    }
}

__device__ __forceinline__ void phase5(const Params& p) {
    const int tid = threadIdx.x, lane = tid & 63, wave = tid >> 6;
    const float* MOD = (const float*)(p.ws + WS_MOD); bf16* XN = (bf16*)(p.ws + WS_XN); const float* MIX = (const float*)(p.ws + WS_MIX);
    const int gw = blockIdx.x * NWAVES + wave, NGW = gridDim.x * NWAVES;
    for (int row = gw; row < M; row += NGW) {
        const float* xr = row < MP ? p.xp + (size_t)row * D : p.xs + (size_t)(row - MP) * D;
        const int r = row < MP ? 0 : 1 + ((row - MP) >> 10);
        const float* mr = MOD + r * 6144;
        f32x4 v[4], mv[4]; float s2 = 0.f;
#pragma unroll
        for (int j = 0; j < 4; ++j) { mv[j] = ((const f32x4*)(MIX + (size_t)row * D))[lane + 64 * j]; v[j] = ((const f32x4*)xr)[lane + 64 * j]; s2 += (mv[j][0] * mv[j][0] + mv[j][1] * mv[j][1]) + (mv[j][2] * mv[j][2] + mv[j][3] * mv[j][3]); }
        const float rstd = 1.0f / sqrtf(wave_sum(s2) * (1.f / D) + EPS);
        float t2 = 0.f;
#pragma unroll
        for (int j = 0; j < 4; ++j) { const int q = lane + 64 * j;
            const f32x4 gp = ((const f32x4*)p.g_attn_post)[q], ga = ((const f32x4*)(mr + 2048))[q];
            v[j] = v[j] + ga * (mv[j] * rstd * gp);
            ((f32x4*)(p.out + O_Y + (size_t)row * D))[q] = v[j];
            t2 += (v[j][0] * v[j][0] + v[j][1] * v[j][1]) + (v[j][2] * v[j][2] + v[j][3] * v[j][3]); }
        const float rstd2 = 1.0f / sqrtf(wave_sum(t2) * (1.f / D) + EPS);
#pragma unroll
        for (int j = 0; j < 4; ++j) { const int q = lane + 64 * j;
            const f32x4 g = ((const f32x4*)p.g_mlp_pre)[q], sh = ((const f32x4*)(mr + 3072))[q], sc = ((const f32x4*)(mr + 4096))[q];
            const f32x4 h = (v[j] * rstd2 * g) * (sc + 1.0f) + sh;
            v2u w; w.x = pk2(h[0], h[1]); w.y = pk2(h[2], h[3]); ((v2u*)(XN + (size_t)row * D))[q] = w; }
    }
}
__device__ __forceinline__ void phase8(const Params& p) {
    const int tid = threadIdx.x, lane = tid & 63, wave = tid >> 6;
    const float* MOD = (const float*)(p.ws + WS_MOD); const float* F = (const float*)(p.ws + WS_F);
    const int gw = blockIdx.x * NWAVES + wave, NGW = gridDim.x * NWAVES;
    for (int row = gw; row < M; row += NGW) {
        const int r = row < MP ? 0 : 1 + ((row - MP) >> 10);
        const float* mr = MOD + r * 6144; float* yr = p.out + O_Y + (size_t)row * D;
        f32x4 v[4], fv[4]; float s2 = 0.f;
#pragma unroll
        for (int j = 0; j < 4; ++j) { fv[j] = ((const f32x4*)(F + (size_t)row * D))[lane + 64 * j]; v[j] = ((const f32x4*)yr)[lane + 64 * j]; s2 += (fv[j][0] * fv[j][0] + fv[j][1] * fv[j][1]) + (fv[j][2] * fv[j][2] + fv[j][3] * fv[j][3]); }
        const float rstd = 1.0f / sqrtf(wave_sum(s2) * (1.f / D) + EPS);
#pragma unroll
        for (int j = 0; j < 4; ++j) { const int q = lane + 64 * j;
            const f32x4 gp = ((const f32x4*)p.g_mlp_post)[q], ga = ((const f32x4*)(mr + 5120))[q];
            ((f32x4*)yr)[q] = v[j] + ga * (fv[j] * rstd * gp); }
    }
}

#define RLX_AGENT __ATOMIC_RELAXED, __HIP_MEMORY_SCOPE_AGENT
#define XB_TMO      128
#define XB_XCNT(j)  (256  + 64 * (j))
#define XB_XSUB(j)  (1280 + 64 * (j))
#define XB_XGEN(j)  (2304 + 64 * (j))
#define XB_TOP      3328
#define XB_TOPGEN   3392
#define XCD_BAR_WORDS 3456
#define XB_SPIN_CAP (1u << 18)

__device__ __forceinline__ unsigned xb_ld(unsigned* p)              { return __hip_atomic_load(p, __ATOMIC_RELAXED, __HIP_MEMORY_SCOPE_AGENT); }
__device__ __forceinline__ unsigned xb_add(unsigned* p, unsigned v) { return __hip_atomic_fetch_add(p, v, __ATOMIC_RELAXED, __HIP_MEMORY_SCOPE_AGENT); }
__device__ __forceinline__ unsigned xb_xcc_id() { return (unsigned)__builtin_amdgcn_s_getreg((3 << 11) | 20) & 0xFu; }
#define XB_SPIN(cond, bar) do { unsigned _sp = 0; while (cond) { __builtin_amdgcn_s_sleep(1); \
    if ((++_sp & 255u) == 0u) { if (xb_ld(&(bar)[XB_TMO])) break; if (_sp > XB_SPIN_CAP) { atomicAdd(&(bar)[XB_TMO], 1u); break; } } } } while (0)

struct XcdBarrier {
    unsigned* bar; unsigned x;
    volatile LAS unsigned* st;
};

__device__ __forceinline__ XcdBarrier xcd_barrier_post(unsigned* bar, volatile LAS unsigned* st) {
    XcdBarrier b; b.bar = bar; b.x = xb_xcc_id(); b.st = st;
    if (threadIdx.x == 0) (void)xb_add(&bar[XB_XCNT(b.x)], 1u);
    return b;
}
__device__ __forceinline__ void xcd_barrier_complete(unsigned* bar, unsigned x, unsigned& nloc, unsigned& nx) {
    const unsigned G = gridDim.x * gridDim.y * gridDim.z;
    unsigned sum, cnt, mine, sp = 0u;
    for (;;) {
        sum = 0u; cnt = 0u; mine = 0u;
#pragma unroll
        for (unsigned j = 0; j < 16; ++j) { const unsigned c = xb_ld(&bar[XB_XCNT(j)]); sum += c; cnt += (c > 0u) ? 1u : 0u; mine = (j == x) ? c : mine; }
        if (sum == G) break;
        __builtin_amdgcn_s_sleep(1);
        if ((++sp & 255u) == 0u) { if (xb_ld(&bar[XB_TMO])) break; if (sp > XB_SPIN_CAP) { atomicAdd(&bar[XB_TMO], 1u); break; } }
    }
    nloc = mine > 0u ? mine : 1u; nx = cnt > 0u ? cnt : 1u;
}

__device__ __forceinline__ void xcd_barrier(const XcdBarrier& b) {
    asm volatile("s_waitcnt vmcnt(0)" ::: "memory");
    __syncthreads();
    if (threadIdx.x == 0) {
        unsigned* bar = b.bar;
        __builtin_amdgcn_s_waitcnt(0);
        unsigned nloc = b.st[0], nx = b.st[1];
        if (nloc == 0u) { xcd_barrier_complete(bar, b.x, nloc, nx); b.st[0] = nloc; b.st[1] = nx; }
        const unsigned old = xb_add(&bar[XB_XSUB(b.x)], 1u);
        const unsigned gen = old / nloc;
        if (old + 1u == (gen + 1u) * nloc) {
            __builtin_amdgcn_fence(__ATOMIC_RELEASE, "agent");
            asm volatile("s_waitcnt vmcnt(0)" ::: "memory");
            const unsigned og = xb_add(&bar[XB_TOP], 1u);
            const unsigned tg = og / nx;
            if (og + 1u == (tg + 1u) * nx) xb_add(&bar[XB_TOPGEN], 1u);
            else XB_SPIN(xb_ld(&bar[XB_TOPGEN]) == tg, bar);
            __builtin_amdgcn_fence(__ATOMIC_ACQUIRE, "agent");
            xb_add(&bar[XB_XGEN(b.x)], 1u);
            asm volatile("s_waitcnt vmcnt(0)" ::: "memory");
        } else {
            XB_SPIN(xb_ld(&bar[XB_XGEN(b.x)]) == gen, bar);
            __builtin_amdgcn_fence(__ATOMIC_ACQUIRE, "agent");
            asm volatile("s_waitcnt vmcnt(0)" ::: "memory");
        }
    }
    __syncthreads();
}

constexpr int N_PHASES = 9;
__global__ void __launch_bounds__(NTHR, 2) fwd_megakernel(Params p) {
    extern __shared__ __attribute__((aligned(16))) unsigned char lds_raw[];
    LAS unsigned char* lds = (LAS unsigned char*)lds_raw;
    cg::grid_group grid = cg::this_grid();
    unsigned char* ws = p.ws;
    const int lo = p.ph_lo, hi = p.ph_hi;
    for (int u = threadIdx.x; u < 64; u += NTHR) ((LAS unsigned*)(lds + 131072))[u] = 0u;
    __syncthreads();
    XcdBarrier bar = xcd_barrier_post((unsigned*)ws + 4096, (volatile LAS unsigned*)(lds + 131072));
#define IN(k) (lo <= (k) && (k) < hi)
#ifndef REP_SYNC
#define REP_SYNC 1
#endif
#define SEAM(k) do { if (IN(k) && IN((k) + 1)) { for (int rs = 0; rs < REP_SYNC; ++rs) { if (USE_CG_SYNC || p.ph_lo == 12345) grid.sync(); else xcd_barrier(bar); } } } while (0)
    if (IN(0)) { for (int rep = 0; rep < REP_P0; ++rep) { phase0(p, lds); __syncthreads(); } } SEAM(0);
    if (IN(1)) { phase1(p); } SEAM(1);
    if (IN(2)) _Pragma("unroll") for (int rep = 0; rep < REP_P2; ++rep) {
        pg8::Gemm gm{(const bf16*)(ws + WS_XN), (const bf16*)(ws + WS_WIN), M, NPP, D}; pg8::StaticOrder S; S.init(M, NPP, gridDim.x, (int)blockIdx.x);
        pg8::EpiInProj E{(bf16*)(ws + WS_PROJ), (float*)(ws + WS_GATE), p.out + O_NK, p.out + O_NV, (const float*)(ws + WS_ROPE), (const float*)(ws + WS_ROPE) + 1024};
        pg8::gemm_phase<pg8::EpiInProj, pg8::StaticOrder, true, true>(lds, gm, S, E);
    } SEAM(2);
    if (IN(3)) { phase3(p, lds); } SEAM(3);
    if (IN(4)) { phase_gla_inter(p, lds); if (IN(5)) xcd_barrier(bar); phase3b(p); } SEAM(4);
    if (IN(5)) _Pragma("unroll") for (int rep = 0; rep < REP_P5; ++rep) {
        pg8::Gemm gm{(const bf16*)(ws + WS_A2), (const bf16*)(ws + WS_WOUT), M, D, D}; pg8::StaticOrder S; S.init(M, D, gridDim.x, (int)blockIdx.x);
        pg8::EpiF32 E{(float*)(ws + WS_MIX), D};
        pg8::gemm_phase<pg8::EpiF32, pg8::StaticOrder, true, true>(lds, gm, S, E);
    } SEAM(5);
    if (IN(6)) { phase5(p); } SEAM(6);
    if (IN(7)) _Pragma("unroll") for (int rep = 0; rep < REP_P7; ++rep) {
        pg8::Gemm gm{(const bf16*)(ws + WS_XN), (const bf16*)(ws + WS_W1), M, FF, D}; pg8::StaticOrder S; S.init(M, FF, gridDim.x, (int)blockIdx.x);
        pg8::EpiRelu2 E{(bf16*)(ws + WS_H), FF};
        pg8::gemm_phase<pg8::EpiRelu2, pg8::StaticOrder, true, true>(lds, gm, S, E);
    } SEAM(7);
    if (IN(8)) _Pragma("unroll") for (int rep = 0; rep < REP_P8; ++rep) {
        pg8::Gemm gm{(const bf16*)(ws + WS_H), (const bf16*)(ws + WS_W2), M, D, FF}; pg8::StaticOrder S; S.init(M, D, gridDim.x, (int)blockIdx.x);
        pg8::EpiF32 E{(float*)(ws + WS_F), D};
        pg8::gemm_phase<pg8::EpiF32, pg8::StaticOrder, true, true>(lds, gm, S, E);
    } SEAM(8);
    if (IN(9)) { phase8(p); }
#undef IN
#undef SEAM
}

extern "C" void kernel_launch(void* const* d_in, const int* in_sizes, int n_in, void* d_out, int out_size, void* d_ws, size_t ws_size, hipStream_t stream) {
    static int grid = 0;
    if (grid == 0) {
        int dev = 0, cus = 0, per_cu = 0;
        hipGetDevice(&dev); hipDeviceGetAttribute(&cus, hipDeviceAttributeMultiprocessorCount, dev);
        if (hipFuncSetAttribute((const void*)fwd_megakernel, hipFuncAttributeMaxDynamicSharedMemorySize, LDS_BYTES) != hipSuccess) { fprintf(stderr, "hipFuncSetAttribute failed\n"); }
        if (hipOccupancyMaxActiveBlocksPerMultiprocessor(&per_cu, (const void*)fwd_megakernel, NTHR, LDS_BYTES) != hipSuccess || per_cu < 1) { fprintf(stderr, "occupancy query: %d\n", per_cu); per_cu = 1; }
        (void)hipGetLastError();
        grid = cus * 1;
        if (grid <= 0) grid = 256;
    }
    if (hipMemsetAsync(d_ws, 0, 65536, stream) != hipSuccess) fprintf(stderr, "memset failed\n");
    Params p{};
    const float* const* in = (const float* const*)d_in;
    p.xp = in[0]; p.xs = in[1]; p.c = in[2]; p.cache_k = in[3]; p.cache_v = in[4]; p.state_f = in[5]; p.state_b = in[6]; p.c_ctx = in[7]; p.w_ada = in[8]; p.b_ada = in[9];
    p.g_attn_pre = in[10]; p.g_attn_post = in[11]; p.g_mlp_pre = in[12]; p.g_mlp_post = in[13]; p.w_in = in[14]; p.wg_f = in[15]; p.bg_f = in[16]; p.wg_b = in[17]; p.bg_b = in[18];
    p.lq1 = in[19]; p.lk1 = in[20]; p.lq2 = in[21]; p.lk2 = in[22]; p.diff_norm = in[23]; p.gla_norm = in[24]; p.w_out = in[25]; p.w_mlp1 = in[26]; p.w_mlp2 = in[27];
    p.out = (float*)d_out; p.ws = (unsigned char*)d_ws;
#if MK_N_LAUNCHES == 1
    p.ph_lo = 0; p.ph_hi = N_PHASES + 1;
    void* args[] = {&p};
    hipError_t e = hipLaunchCooperativeKernel((const void*)fwd_megakernel, dim3(grid), dim3(NTHR), args, LDS_BYTES, stream);
    if (e != hipSuccess) fprintf(stderr, "cooperative launch failed: %s (grid %d)\n", hipGetErrorString(e), grid);
#else
    for (int k = 0; k <= N_PHASES; ++k) { p.ph_lo = k; p.ph_hi = k + 1; hipLaunchKernelGGL(fwd_megakernel, dim3(grid), dim3(NTHR), LDS_BYTES, stream, p); }
#endif
}
```

```cpp
#include <hip/hip_runtime.h>
#include <hip/hip_cooperative_groups.h>
#include <cstdio>
#include <cstdint>
#include <cmath>
namespace cg = cooperative_groups;
namespace pg8 {
#define PG8_LAS __attribute__((address_space(3)))
typedef unsigned short bf16_t;
typedef short bf16x8 __attribute__((ext_vector_type(8)));
typedef float f32x4 __attribute__((ext_vector_type(4)));
typedef unsigned u32x4 __attribute__((ext_vector_type(4)));
constexpr int BM = 256, BK = 64, HALF = 128, HTB = HALF * BK * 2  , STAGE_BYTES = 8 * HTB, NXCD = 8, WGM = 8;

__host__ __device__ __forceinline__ int lds_byte(int r, int c) { const int st = (r >> 4) * 2 + (c >> 5), rr = r & 15, cc = c & 31, ob = rr * 64 + cc * 2; return st * 1024 + (ob ^ (((ob >> 9) & 1) << 5)); }
__host__ __device__ __forceinline__ void stage_rc(int b, int& R, int& C) { const int st = b / 1024, sb = b % 1024, swz = sb ^ (((sb >> 9) & 1) << 5); R = (st >> 1) * 16 + swz / 64; C = (st & 1) * 32 + (swz % 64) / 2; }
__host__ __device__ __forceinline__ int perm32(int rho) { const int n = rho >> 4, i = rho & 15; return 8 * (i >> 2) + 4 * n + (i & 3); }

struct Unit { int pm, pn; };
struct Gemm { const bf16_t* A; const bf16_t* Bt; int M, N, K; };

struct StaticOrder {
    int nM, nN, nwg, G, c;
    __host__ __device__ void init(int M, int N, int G_, int c_) { nM = M / BM; nN = N / BM; nwg = nM * nN; G = G_; c = c_; }
    __host__ __device__ bool next(int i, Unit& u) const {
        const long L = (long)i * G + c; if (L >= nwg) return false;
        int wgid = (int)L; { const int q = nwg / NXCD, r = nwg % NXCD, xcd = wgid % NXCD, off = wgid / NXCD; wgid = (xcd < r ? xcd * (q + 1) : r * (q + 1) + (xcd - r) * q) + off; }
        const int nig = WGM * nN, gid = wgid / nig, fm = gid * WGM, gsz = (nM - fm) < WGM ? (nM - fm) : WGM;
        u.pm = fm + ((wgid % nig) % gsz); u.pn = (wgid % nig) / gsz; return true;
    }
    __device__ __forceinline__ void a_ready(const Unit&) const {}
    __device__ __forceinline__ void done(const Unit&) const {}
};

__device__ __forceinline__ unsigned cvt_pk_bf16(float lo, float hi) { unsigned r; asm volatile("v_cvt_pk_bf16_f32 %0, %1, %2" : "=v"(r) : "v"(lo), "v"(hi)); return r; }
typedef float f32x2 __attribute__((ext_vector_type(2)));
template <class Epi, class Sched, bool ALIGN_EPI = false, bool SP2 = false>
__device__ __forceinline__ void gemm_phase(PG8_LAS unsigned char* lds, const Gemm g, const Sched& S, const Epi& E) {
    const int tid = threadIdx.x, wid = __builtin_amdgcn_readfirstlane(tid >> 6), lane = tid & 63, wr = wid >> 2, wc = wid & 3, fr = lane & 15, fq = lane >> 4;
    const int K = g.K, nt = K / BK;
    unsigned voffA[2], voffB[2];
#pragma unroll
    for (int i = 0; i < 2; ++i) { int R, C; stage_rc(tid * 16 + i * 8192, R, C); const int Rb = Epi::PERM ? ((R & ~31) + perm32(R & 31)) : R;
        voffA[i] = (unsigned)(R * K + C) * 2u; voffB[i] = (unsigned)(Rb * K + C) * 2u; }
    const size_t kstep = (size_t)(BK * 2);
    const size_t hstep = (size_t)HALF * K * 2;
    const size_t tstep = 2 * hstep;
    const unsigned ldsw = (unsigned)wid * 1024u;
    const int aoff = lds_byte(wr * 64 + fr, fq * 8), boff = lds_byte(wc * 32 + fr, fq * 8);
#define PG8_SA(b, h) (((b) * 2 + (h)) * HTB)
#define PG8_SB(b, h) ((4 + (b) * 2 + (h)) * HTB)
#define PG8_STAGE(bufoff, gbase, voff) do { _Pragma("unroll") for (int _i = 0; _i < 2; ++_i) \
        __builtin_amdgcn_global_load_lds((const unsigned*)((const char*)(gbase) + (voff)[_i]), (PG8_LAS unsigned*)(lds + (bufoff) + ldsw + _i * 8192), 16, 0, 0); } while (0)
#define PG8_LDA(dst, b, h) do { _Pragma("unroll") for (int m = 0; m < 4; ++m) _Pragma("unroll") for (int k = 0; k < 2; ++k) dst[m][k] = *(const PG8_LAS bf16x8*)(lds + PG8_SA(b, h) + aoff + m * 2048 + k * 1024); } while (0)
#define PG8_LDB(dst, b, h) do { _Pragma("unroll") for (int n = 0; n < 2; ++n) _Pragma("unroll") for (int k = 0; k < 2; ++k) dst[n][k] = *(const PG8_LAS bf16x8*)(lds + PG8_SB(b, h) + boff + n * 2048 + k * 1024); } while (0)
#define PG8_MMA(ai, bj, At, Bt) do { __builtin_amdgcn_s_setprio(1); _Pragma("unroll") for (int m = 0; m < 4; ++m) _Pragma("unroll") for (int n = 0; n < 2; ++n) _Pragma("unroll") for (int k = 0; k < 2; ++k) \
        acc[ai][bj][m][n] = __builtin_amdgcn_mfma_f32_16x16x32_bf16(Bt[n][k], At[m][k], acc[ai][bj][m][n], 0, 0, 0); __builtin_amdgcn_s_setprio(0); } while (0)
#define PG8_WAIT_V(n) asm volatile("s_waitcnt vmcnt(" #n ")" ::: "memory")
#define PG8_WAIT_L(n) asm volatile("s_waitcnt lgkmcnt(" #n ")" ::: "memory")
#define PG8_BAR __builtin_amdgcn_s_barrier()
#define PG8_SCHED __builtin_amdgcn_sched_barrier(0)
    Unit cur, nxt; int ui = 0;
    if (!S.next(0, cur)) return;
    f32x4 acc[2][2][4][2];
#pragma unroll
    for (int a = 0; a < 2; ++a)
#pragma unroll
        for (int b = 0; b < 2; ++b)
#pragma unroll
            for (int m = 0; m < 4; ++m)
#pragma unroll
                for (int n = 0; n < 2; ++n) acc[a][b][m][n] = (f32x4){0.f, 0.f, 0.f, 0.f};
    bf16x8 At[4][2], B0[2][2], B1[2][2];
    const char* cA = (const char*)g.A + (size_t)cur.pm * tstep; const char* cB = (const char*)g.Bt + (size_t)cur.pn * tstep;
    S.a_ready(cur);
    if constexpr (SP2) {
        PG8_STAGE(PG8_SB(0, 0), cB, voffB); PG8_STAGE(PG8_SB(0, 1), cB + hstep, voffB); PG8_STAGE(PG8_SA(0, 0), cA, voffA); PG8_STAGE(PG8_SA(0, 1), cA + hstep, voffA);
        if (wr == 1) PG8_BAR;
        PG8_WAIT_V(2); PG8_BAR;
        PG8_STAGE(PG8_SB(1, 0), cB + kstep, voffB); PG8_STAGE(PG8_SA(1, 0), cA + kstep, voffA); PG8_STAGE(PG8_SB(1, 1), cB + hstep + kstep, voffB);
        PG8_WAIT_V(6); PG8_BAR;
    } else {
        PG8_STAGE(PG8_SB(0, 0), cB, voffB); PG8_STAGE(PG8_SA(0, 0), cA, voffA); PG8_STAGE(PG8_SB(0, 1), cB + hstep, voffB); PG8_STAGE(PG8_SA(0, 1), cA + hstep, voffA);
        if (wr == 1) PG8_BAR;
        PG8_WAIT_V(4); PG8_BAR;
        PG8_STAGE(PG8_SB(1, 0), cB + kstep, voffB); PG8_STAGE(PG8_SA(1, 0), cA + kstep, voffA); PG8_STAGE(PG8_SB(1, 1), cB + hstep + kstep, voffB);
        PG8_WAIT_V(6); PG8_BAR;
    }
    for (;;) {
        const bool has_next = S.next(ui + 1, nxt);
        const char* nA = has_next ? (const char*)g.A + (size_t)nxt.pm * tstep : cA; const char* nB = has_next ? (const char*)g.Bt + (size_t)nxt.pn * tstep : cB;
        for (int t = 0; t < nt; t += 2) {
            const bool last = (t == nt - 2);
            const char* a1 = cA + (size_t)(t + 1) * kstep;
            const char* a2 = last ? nA : cA + (size_t)(t + 2) * kstep; const char* b2 = last ? nB : cB + (size_t)(t + 2) * kstep;
            const char* a3 = a2 + kstep; const char* b3 = b2 + kstep;
            if (last && has_next) S.a_ready(nxt);
            if constexpr (SP2) {
            PG8_LDB(B0, 0, 0); PG8_LDB(B1, 0, 1); PG8_SCHED; PG8_LDA(At, 0, 0); PG8_STAGE(PG8_SA(1, 1), a1 + hstep, voffA);
            PG8_WAIT_V(8); PG8_WAIT_L(0); PG8_BAR; PG8_MMA(0, 0, At, B0); PG8_MMA(0, 1, At, B1); PG8_BAR; PG8_SCHED;
            PG8_LDA(At, 0, 1); PG8_STAGE(PG8_SB(0, 0), b2, voffB); PG8_STAGE(PG8_SB(0, 1), b2 + hstep, voffB); PG8_STAGE(PG8_SA(0, 0), a2, voffA);
            PG8_WAIT_V(8); PG8_WAIT_L(0); PG8_BAR; PG8_MMA(1, 0, At, B0); PG8_MMA(1, 1, At, B1); PG8_BAR; PG8_SCHED;
            PG8_LDB(B0, 1, 0); PG8_LDB(B1, 1, 1); PG8_SCHED; PG8_LDA(At, 1, 0); PG8_STAGE(PG8_SA(0, 1), a2 + hstep, voffA);
            PG8_WAIT_V(8); PG8_WAIT_L(0); PG8_BAR; PG8_MMA(0, 0, At, B0); PG8_MMA(0, 1, At, B1); PG8_BAR; PG8_SCHED;
            PG8_LDA(At, 1, 1); PG8_STAGE(PG8_SB(1, 0), b3, voffB); PG8_STAGE(PG8_SB(1, 1), b3 + hstep, voffB); PG8_STAGE(PG8_SA(1, 0), a3, voffA);
            PG8_WAIT_V(8); PG8_WAIT_L(0); PG8_BAR; PG8_MMA(1, 0, At, B0); PG8_MMA(1, 1, At, B1); PG8_BAR; PG8_SCHED;
            } else {
            PG8_LDB(B0, 0, 0); PG8_SCHED; PG8_LDA(At, 0, 0); PG8_STAGE(PG8_SA(1, 1), a1 + hstep, voffA);
            PG8_WAIT_L(8); PG8_BAR; PG8_WAIT_L(0); PG8_MMA(0, 0, At, B0); PG8_BAR; PG8_SCHED;
            PG8_LDB(B1, 0, 1); PG8_STAGE(PG8_SB(0, 0), b2, voffB);
            PG8_BAR; PG8_WAIT_L(0); PG8_MMA(0, 1, At, B1); PG8_BAR;
            PG8_LDA(At, 0, 1); PG8_STAGE(PG8_SA(0, 0), a2, voffA);
            PG8_BAR; PG8_WAIT_L(0); PG8_MMA(1, 0, At, B0); PG8_BAR; PG8_SCHED;
            PG8_STAGE(PG8_SB(0, 1), b2 + hstep, voffB);
            PG8_WAIT_V(6); PG8_BAR; PG8_MMA(1, 1, At, B1); PG8_BAR;
            PG8_LDB(B0, 1, 0); PG8_SCHED; PG8_LDA(At, 1, 0); PG8_STAGE(PG8_SA(0, 1), a2 + hstep, voffA);
            PG8_WAIT_L(8); PG8_BAR; PG8_WAIT_L(0); PG8_MMA(0, 0, At, B0); PG8_BAR; PG8_SCHED;
            PG8_LDB(B1, 1, 1); PG8_STAGE(PG8_SB(1, 0), b3, voffB);
            PG8_BAR; PG8_WAIT_L(0); PG8_MMA(0, 1, At, B1); PG8_BAR;
            PG8_LDA(At, 1, 1); PG8_STAGE(PG8_SA(1, 0), a3, voffA);
            PG8_BAR; PG8_WAIT_L(0); PG8_MMA(1, 0, At, B0); PG8_BAR; PG8_SCHED;
            PG8_STAGE(PG8_SB(1, 1), b3 + hstep, voffB);
            PG8_WAIT_V(6); PG8_BAR; PG8_MMA(1, 1, At, B1); PG8_BAR;
            }
        }
        if constexpr (ALIGN_EPI) { if (wr == 0) PG8_BAR; }
        if constexpr (!Epi::AFTER_DRAIN) { E(acc, cur, wr, wc, fr, fq); S.done(cur); }
        if (!has_next) break;
#pragma unroll
        for (int a = 0; a < 2; ++a)
#pragma unroll
            for (int b = 0; b < 2; ++b)
#pragma unroll
                for (int m = 0; m < 4; ++m)
#pragma unroll
                    for (int n = 0; n < 2; ++n) acc[a][b][m][n] = (f32x4){0.f, 0.f, 0.f, 0.f};
        cur = nxt; cA = nA; cB = nB; ++ui;
        if constexpr (ALIGN_EPI) { if (wr == 1) PG8_BAR; }
    }
    PG8_WAIT_V(0);
    if constexpr (!ALIGN_EPI) { if (wr == 0) PG8_BAR; }
    PG8_BAR;
    if constexpr (Epi::AFTER_DRAIN) { E.fused(acc, cur, wr, wc, fr, fq, lds, wid, lane); S.done(cur); }
#undef PG8_SA
#undef PG8_SB
#undef PG8_STAGE
#undef PG8_LDA
#undef PG8_LDB
#undef PG8_MMA
#undef PG8_WAIT_V
#undef PG8_WAIT_L
#undef PG8_BAR
#undef PG8_SCHED
}
}

#ifndef REP_P0
#define REP_P0 1
#endif
#ifndef REP_P2
#define REP_P2 1
#endif
#ifndef REP_ATT
#define REP_ATT 1
#endif
#ifndef REP_GLA
#define REP_GLA 1
#endif
#ifndef REP_P5
#define REP_P5 1
#endif
#ifndef REP_P7
#define REP_P7 1
#endif
#ifndef REP_P8
#define REP_P8 1
#endif
#ifndef USE_CG_SYNC
#define USE_CG_SYNC 0
#endif
#ifndef MK_N_LAUNCHES
#define MK_N_LAUNCHES 1
#endif
#define LAS __attribute__((address_space(3)))
typedef unsigned short bf16;
typedef unsigned v4u __attribute__((ext_vector_type(4)));
typedef unsigned v2u __attribute__((ext_vector_type(2)));
typedef float f32x4 __attribute__((ext_vector_type(4)));
typedef short bf16x8 __attribute__((ext_vector_type(8)));
typedef short s16x4 __attribute__((ext_vector_type(4)));

constexpr int D = 1024, M = 16384, MP = 8192, NPROJ = 3104, NPP = 3328, FF = 4096;
constexpr int C_QA = 0, C_KA = 512, C_VA = 1024, C_QB = 1536, C_KB = 1792, C_VB = 2048, C_RB = 2560, C_GL = 3072;
constexpr float EPS = 1e-6f;
constexpr int NWAVES = 8, NTHR = 512;
constexpr int LDS_BYTES = 147456;

constexpr size_t MiB = 1u << 20;
constexpr size_t WS_WIN = 2 * MiB, WS_WOUT = 9 * MiB, WS_W1 = 11 * MiB, WS_W2 = 19 * MiB;
constexpr size_t WS_MOD = 27 * MiB, WS_ROPE = 27 * MiB + 240 * 1024, WS_CK = 28 * MiB, WS_CV = 30 * MiB;
constexpr size_t WS_XN = 32 * MiB, WS_PROJ = 64 * MiB, WS_GATE = 168 * MiB, WS_A2 = 170 * MiB, WS_OGF = 202 * MiB, WS_OGB = 218 * MiB;
constexpr size_t WS_MIX = 64 * MiB, WS_H = 64 * MiB, WS_F = 192 * MiB;
constexpr size_t O_Y = 0, O_NK = 16777216, O_NV = 20971520, O_SF = 25165824, O_SB = 26214400;

struct Params {
    const float *xp, *xs, *c, *cache_k, *cache_v, *state_f, *state_b, *c_ctx, *w_ada, *b_ada;
    const float *g_attn_pre, *g_attn_post, *g_mlp_pre, *g_mlp_post, *w_in, *wg_f, *bg_f, *wg_b, *bg_b;
    const float *lq1, *lk1, *lq2, *lk2, *diff_norm, *gla_norm, *w_out, *w_mlp1, *w_mlp2;
    float* out; unsigned char* ws;
    int ph_lo, ph_hi;
};

__device__ __forceinline__ unsigned f2bf(float f) { unsigned u = __builtin_bit_cast(unsigned, f); return (u + 0x7fffu + ((u >> 16) & 1u)) >> 16; }
__device__ __forceinline__ unsigned pk2(float lo, float hi) { return f2bf(lo) | (f2bf(hi) << 16); }
__device__ __forceinline__ float bf2f(unsigned short b) { return __builtin_bit_cast(float, (unsigned)b << 16); }
__device__ __forceinline__ float bflo(unsigned w) { return __builtin_bit_cast(float, w << 16); }
__device__ __forceinline__ float bfhi(unsigned w) { return __builtin_bit_cast(float, w & 0xffff0000u); }
__device__ __forceinline__ float wave_sum(float v) {
#pragma unroll
    for (int o = 1; o < 64; o <<= 1) v += __shfl_xor(v, o);
    return v;
}
__device__ __forceinline__ s16x4 trrd(const LAS unsigned char* p) { return __builtin_bit_cast(s16x4, __builtin_amdgcn_ds_read_tr16_b64_v4i16((LAS s16x4*)p)); }
__device__ __forceinline__ bf16x8 cat4(s16x4 lo, s16x4 hi) { return (bf16x8){lo[0], lo[1], lo[2], lo[3], hi[0], hi[1], hi[2], hi[3]}; }
__device__ __forceinline__ bf16x8 pack8(f32x4 a, f32x4 b) { v4u w; w.x = pk2(a[0], a[1]); w.y = pk2(a[2], a[3]); w.z = pk2(b[0], b[1]); w.w = pk2(b[2], b[3]); return __builtin_bit_cast(bf16x8, w); }
#define MFMA16(a, b, c) __builtin_amdgcn_mfma_f32_16x16x32_bf16((a), (b), (c), 0, 0, 0)

namespace pg8 {
struct EpiF32 {
    static constexpr bool PERM = true, AFTER_DRAIN = false;
    float* O; int ldc;
    __device__ __forceinline__ void operator()(const f32x4 (&acc)[2][2][4][2], const Unit& u, int wr, int wc, int fr, int fq) const {
#pragma unroll
        for (int ai = 0; ai < 2; ++ai)
#pragma unroll
            for (int m = 0; m < 4; ++m) { float* rp = O + (size_t)(u.pm * BM + ai * HALF + wr * 64 + m * 16 + fr) * ldc + u.pn * BM + wc * 32 + 8 * fq;
#pragma unroll
                for (int bj = 0; bj < 2; ++bj) { *(f32x4*)(rp + bj * HALF) = acc[ai][bj][m][0]; *(f32x4*)(rp + bj * HALF + 4) = acc[ai][bj][m][1]; } }
    }
};
struct EpiRelu2 {
    static constexpr bool PERM = true, AFTER_DRAIN = false;
    bf16_t* O; int ldc;
    __device__ __forceinline__ void operator()(const f32x4 (&acc)[2][2][4][2], const Unit& u, int wr, int wc, int fr, int fq) const {
#pragma unroll
        for (int ai = 0; ai < 2; ++ai)
#pragma unroll
            for (int m = 0; m < 4; ++m) { bf16_t* rp = O + (size_t)(u.pm * BM + ai * HALF + wr * 64 + m * 16 + fr) * ldc + u.pn * BM + wc * 32 + 8 * fq;
#pragma unroll
                for (int bj = 0; bj < 2; ++bj) { f32x4 a = acc[ai][bj][m][0], b = acc[ai][bj][m][1];
#pragma unroll
                    for (int j = 0; j < 4; ++j) { a[j] = a[j] > 0.f ? a[j] * a[j] : 0.f; b[j] = b[j] > 0.f ? b[j] * b[j] : 0.f; }
                    u32x4 w; w.x = cvt_pk_bf16(a[0], a[1]); w.y = cvt_pk_bf16(a[2], a[3]); w.z = cvt_pk_bf16(b[0], b[1]); w.w = cvt_pk_bf16(b[2], b[3]);
                    *(u32x4*)(rp + bj * HALF) = w; } }
    }
};
struct EpiInProj {
    static constexpr bool PERM = false, AFTER_DRAIN = false;
    bf16_t* P; float* GATE; float* newk; float* newv; const float* COS; const float* SIN;
    __device__ __forceinline__ void operator()(const f32x4 (&acc)[2][2][4][2], const Unit& u, int wr, int wc, int fr, int fq) const {
        typedef unsigned u32x2 __attribute__((ext_vector_type(2)));
        const int pn = u.pn;
#pragma unroll
        for (int ai = 0; ai < 2; ++ai)
#pragma unroll
            for (int m = 0; m < 4; ++m) {
                const int row = u.pm * BM + ai * HALF + wr * 64 + m * 16 + fr;
                const bool samp = row >= 8192;
                const int t = (row - 8192) & 1023;
#pragma unroll
                for (int bj = 0; bj < 2; ++bj) {
                    const int col0 = pn * BM + bj * HALF + wc * 32 + 4 * fq;
                    f32x4 v0 = acc[ai][bj][m][0], v1 = acc[ai][bj][m][1];
                    if (pn < 4 && samp) {
                        const int pos = ((col0 >> 5) & 1) ? (t & 63) : (t >> 6);
                        const f32x4 cs = *(const f32x4*)(COS + pos * 16 + 4 * fq), sn = *(const f32x4*)(SIN + pos * 16 + 4 * fq);
                        const f32x4 o0 = v0 * cs - v1 * sn, o1 = v0 * sn + v1 * cs; v0 = o0; v1 = o1;
                    }
                    {
                        bf16_t* pp = P + (size_t)row * 3328 + col0;
                        u32x2 w0, w1; w0.x = cvt_pk_bf16(v0[0], v0[1]); w0.y = cvt_pk_bf16(v0[2], v0[3]); w1.x = cvt_pk_bf16(v1[0], v1[1]); w1.y = cvt_pk_bf16(v1[2], v1[3]);
                        *(u32x2*)pp = w0; *(u32x2*)(pp + 16) = w1;
                        if (!samp && pn >= 2 && pn < 6) {
                            const int cc = (col0 - 512) & 511, hh = cc >> 7, dd = cc & 127;
                            float* op = (pn < 4 ? newk : newv) + ((size_t)((row >> 8) * 4 + hh) * 256 + (row & 255)) * 128 + dd;
                            *(f32x4*)op = v0; *(f32x4*)(op + 16) = v1;
                        }
                    }
                }
            }
    }
};
}

__device__ __forceinline__ void p0_transpose_item(const float* __restrict__ W, int K, int N, bf16* WT, LAS float* scr, int item, int lane) {
    const int nblk = N / 32, kb = item / nblk, nb = item % nblk, k0 = 64 * kb, n0 = 32 * nb;
#pragma unroll 8
    for (int i = 0; i < 32; ++i) { const int kk = 2 * i + (lane >> 5); scr[kk * 33 + (lane & 31)] = W[(size_t)(k0 + kk) * N + n0 + (lane & 31)]; }
    asm volatile("s_waitcnt lgkmcnt(0)" ::: "memory");
    const int c = lane & 7;
#pragma unroll
    for (int j = 0; j < 4; ++j) { const int n = (lane >> 3) + 8 * j; const LAS float* s = scr + (8 * c) * 33 + n;
        v4u o; o.x = pk2(s[0 * 33], s[1 * 33]); o.y = pk2(s[2 * 33], s[3 * 33]); o.z = pk2(s[4 * 33], s[5 * 33]); o.w = pk2(s[6 * 33], s[7 * 33]);
        *(v4u*)(WT + (size_t)(n0 + n) * K + k0 + 8 * c) = o; }
    asm volatile("s_waitcnt lgkmcnt(0)" ::: "memory");
}
__device__ __forceinline__ void sincos_tab(float ang, float& s, float& c) {
    const double x = (double)ang; const double k = rint(x * 0.15915494309189535);
    double r = fma(-k, 6.283185307179586, x); r = fma(-k, 2.4492935982947064e-16, r);
    const double r2 = r * r; double ts = 1.0, tc = 1.0, ss = 1.0, cc = 1.0;
#pragma unroll
    for (int n = 1; n <= 13; ++n) { tc *= -r2 * (1.0 / (double)((2 * n - 1) * (2 * n))); cc += tc; ts *= -r2 * (1.0 / (double)((2 * n) * (2 * n + 1))); ss += ts; }
    s = (float)(r * ss); c = (float)cc;
}
__device__ __forceinline__ void phase0(const Params& p, LAS unsigned char* lds) {
    const int tid = threadIdx.x, lane = tid & 63, wave = __builtin_amdgcn_readfirstlane(tid >> 6);
    unsigned char* ws = p.ws;
    float* MOD = (float*)(ws + WS_MOD);
    {
        LAS float* Ssil = (LAS float*)lds; LAS float* part = (LAS float*)(lds + 36864);
        bool have = false;
        for (int j = blockIdx.x; j < 96; j += gridDim.x) {
            if (!have) {
                for (int i = tid; i < 9 * 1024; i += NTHR) { const int r = i >> 10, k = i & 1023; const float v = (r == 0) ? p.c_ctx[k] : p.c[(r - 1) * 1024 + k]; Ssil[i] = v / (1.f + __expf(-v)); }
                __syncthreads(); have = true;
            }
            float a0 = 0.f, a1 = 0.f, a2 = 0.f, a3 = 0.f, a4 = 0.f, a5 = 0.f, a6 = 0.f, a7 = 0.f, a8 = 0.f;
            const int col = 64 * j + lane, k0 = wave * 128;
            const float* wp = p.w_ada + (size_t)k0 * 6144 + col;
#pragma unroll 8
            for (int kk = 0; kk < 128; ++kk) {
                const float w = wp[(size_t)kk * 6144]; const LAS float* sp = Ssil + k0 + kk;
                a0 += sp[0] * w; a1 += sp[1024] * w; a2 += sp[2048] * w; a3 += sp[3072] * w; a4 += sp[4096] * w; a5 += sp[5120] * w; a6 += sp[6144] * w; a7 += sp[7168] * w; a8 += sp[8192] * w;
            }
            LAS float* pp = part + wave * 576 + lane;
            pp[0] = a0; pp[64] = a1; pp[128] = a2; pp[192] = a3; pp[256] = a4; pp[320] = a5; pp[384] = a6; pp[448] = a7; pp[512] = a8;
            __syncthreads();
            for (int i = tid; i < 576; i += NTHR) { const int r = i >> 6, ci = i & 63; float s = p.b_ada[64 * j + ci];
#pragma unroll
                for (int w = 0; w < 8; ++w) s += part[w * 576 + i];
                MOD[r * 6144 + 64 * j + ci] = s; }
            __syncthreads();
        }
        __syncthreads();
    }
    if (blockIdx.x == gridDim.x - 1) {
        float* COS = (float*)(ws + WS_ROPE); float* SIN = COS + 1024;
        for (int i = tid; i < 1024; i += NTHR) { const int pos = i >> 4, fi = i & 15; const float inv = exp2f(-(float)fi * (13.287712379549449f / 16.f));
            float s, c; sincos_tab((float)pos * inv, s, c); COS[i] = c; SIN[i] = s; }
    }
    {
        LAS float* scr = (LAS float*)(lds + wave * 16384);
        const int gw = blockIdx.x * NWAVES + wave, NGW = gridDim.x * NWAVES;
        constexpr int I_IN = 16 * 97, I_O = 16 * 32, I_1 = 16 * 128, I_2 = 64 * 32, NIT = I_IN + I_O + I_1 + I_2;
        for (int it = gw; it < NIT; it += NGW) {
            int r = it;
            if (r < I_IN) { p0_transpose_item(p.w_in, 1024, NPROJ, (bf16*)(ws + WS_WIN), scr, r, lane); continue; } r -= I_IN;
            if (r < I_O) { p0_transpose_item(p.w_out, 1024, 1024, (bf16*)(ws + WS_WOUT), scr, r, lane); continue; } r -= I_O;
            if (r < I_1) { p0_transpose_item(p.w_mlp1, 1024, 4096, (bf16*)(ws + WS_W1), scr, r, lane); continue; } r -= I_1;
            p0_transpose_item(p.w_mlp2, 4096, 1024, (bf16*)(ws + WS_W2), scr, r, lane);
        }
    }
    {
        const int gt = blockIdx.x * NTHR + tid, NGT = gridDim.x * NTHR;
        v4u* zp = (v4u*)(ws + WS_WIN + (size_t)NPROJ * 1024 * 2);
        for (int i = gt; i < (NPP - NPROJ) * 1024 * 2 / 16; i += NGT) zp[i] = (v4u){0u, 0u, 0u, 0u};
        const f32x4* ck = (const f32x4*)p.cache_k; const f32x4* cv = (const f32x4*)p.cache_v;
        v2u* ok = (v2u*)(ws + WS_CK); v2u* ov = (v2u*)(ws + WS_CV);
        for (int i = gt; i < 262144; i += NGT) { const f32x4 a = ck[i], b = cv[i]; v2u x, y; x.x = pk2(a[0], a[1]); x.y = pk2(a[2], a[3]); y.x = pk2(b[0], b[1]); y.y = pk2(b[2], b[3]); ok[i] = x; ov[i] = y; }
    }
}

__device__ __forceinline__ void phase1(const Params& p) {
    const int tid = threadIdx.x, lane = tid & 63, wave = tid >> 6;
    const float* MOD = (const float*)(p.ws + WS_MOD); bf16* XN = (bf16*)(p.ws + WS_XN);
    const int gw = blockIdx.x * NWAVES + wave, NGW = gridDim.x * NWAVES;
    for (int row = gw; row < M; row += NGW) {
        const float* xr = row < MP ? p.xp + (size_t)row * D : p.xs + (size_t)(row - MP) * D;
        const int r = row < MP ? 0 : 1 + ((row - MP) >> 10);
        f32x4 v[4]; float s2 = 0.f;
#pragma unroll
        for (int j = 0; j < 4; ++j) { v[j] = ((const f32x4*)xr)[lane + 64 * j]; s2 += (v[j][0] * v[j][0] + v[j][1] * v[j][1]) + (v[j][2] * v[j][2] + v[j][3] * v[j][3]); }
        const float rstd = 1.0f / sqrtf(wave_sum(s2) * (1.f / D) + EPS);
        const float* mr = MOD + r * 6144;
#pragma unroll
        for (int j = 0; j < 4; ++j) { const int q = lane + 64 * j;
            const f32x4 g = ((const f32x4*)p.g_attn_pre)[q], sh = ((const f32x4*)mr)[q], sc = ((const f32x4*)(mr + 1024))[q];
            const f32x4 h = (v[j] * rstd * g) * (sc + 1.0f) + sh;
            v2u w; w.x = pk2(h[0], h[1]); w.y = pk2(h[2], h[3]); ((v2u*)(XN + (size_t)row * D))[q] = w; }
    }
}

__device__ __forceinline__ void gate_gemm(const Params& p, LAS unsigned char* lds) {
    const int tid = threadIdx.x, lane = tid & 63, wave = __builtin_amdgcn_readfirstlane(tid >> 6), g = lane >> 4, fr = lane & 15;
    const bf16* XN = (const bf16*)(p.ws + WS_XN); const bf16* Wt = (const bf16*)(p.ws + WS_WIN) + (size_t)3072 * 1024; float* GATE = (float*)(p.ws + WS_GATE);
    for (int rb64 = blockIdx.x; rb64 < M / 64; rb64 += gridDim.x) {
        const int row0 = rb64 * 64, k0 = 128 * wave;
        f32x4 acc[4][2];
#pragma unroll
        for (int rb = 0; rb < 4; ++rb) { acc[rb][0] = (f32x4){0.f, 0.f, 0.f, 0.f}; acc[rb][1] = (f32x4){0.f, 0.f, 0.f, 0.f}; }
#pragma unroll
        for (int ks = 0; ks < 4; ++ks) {
            const bf16x8 b0 = *(const bf16x8*)(Wt + (size_t)fr * 1024 + k0 + 32 * ks + 8 * g), b1 = *(const bf16x8*)(Wt + (size_t)(16 + fr) * 1024 + k0 + 32 * ks + 8 * g);
#pragma unroll
            for (int rb = 0; rb < 4; ++rb) { const bf16x8 a = *(const bf16x8*)(XN + (size_t)(row0 + 16 * rb + fr) * 1024 + k0 + 32 * ks + 8 * g);
                acc[rb][0] = MFMA16(b0, a, acc[rb][0]); acc[rb][1] = MFMA16(b1, a, acc[rb][1]); }
        }
#pragma unroll
        for (int rb = 0; rb < 4; ++rb)
#pragma unroll
            for (int cb = 0; cb < 2; ++cb) *(LAS f32x4*)(lds + ((wave * 8 + rb * 2 + cb) * 64 + lane) * 16) = acc[rb][cb];
        __syncthreads();
        { const int rc = tid >> 6; f32x4 s = *(const LAS f32x4*)(lds + (rc * 64 + lane) * 16);
#pragma unroll
            for (int w = 1; w < 8; ++w) s = s + *(const LAS f32x4*)(lds + ((w * 8 + rc) * 64 + lane) * 16);
            *(f32x4*)(GATE + (size_t)(row0 + 16 * (rc >> 1) + fr) * 32 + 16 * (rc & 1) + 4 * g) = s; }
        __syncthreads();
    }
}

constexpr int KP = 272, VP = 288, KT_BYTES = 64 * KP, VT_BYTES = 64 * VP, ABUF = KT_BYTES + VT_BYTES;
constexpr float CS = 0.125f * 1.4426950408889634f;

__device__ __forceinline__ void att_load(const Params& p, int samp, int b, int h, int t, int tid, v4u (&kr)[2], v4u (&vr)[2]) {
    const bf16* PROJ = (const bf16*)(p.ws + WS_PROJ);
#pragma unroll
    for (int i = 0; i < 2; ++i) {
        const int id = tid + 512 * i, r = id >> 4, ch = id & 15;
        const bf16 *kp, *vp;
        if (samp && t < 4) { const size_t o = ((size_t)(b * 4 + h) * 256 + t * 64 + r) * 128 + ch * 8; kp = (const bf16*)(p.ws + WS_CK) + o; vp = (const bf16*)(p.ws + WS_CV) + o; }
        else { const int row = samp ? (MP + b * 1024 + (t - 4) * 64 + r) : (b * 256 + t * 64 + r); const bf16* rp = PROJ + (size_t)row * NPP + h * 128 + ch * 8; kp = rp + C_KA; vp = rp + C_VA; }
        kr[i] = *(const v4u*)kp; vr[i] = *(const v4u*)vp;
    }
}
__device__ __forceinline__ void att_store(LAS unsigned char* buf, int tid, const v4u (&kr)[2], const v4u (&vr)[2]) {
#pragma unroll
    for (int i = 0; i < 2; ++i) { const int id = tid + 512 * i, r = id >> 4, ch = id & 15;
        *(LAS v4u*)(buf + r * KP + ch * 16) = kr[i]; *(LAS v4u*)(buf + KT_BYTES + r * VP + ch * 16) = vr[i]; }
}
__device__ __forceinline__ void softmax_step(f32x4 (&S)[4], float& m, float& l, f32x4 (&O)[8]) {
    float mx = S[0][0];
#pragma unroll
    for (int kb = 0; kb < 4; ++kb)
#pragma unroll
        for (int r = 0; r < 4; ++r) mx = fmaxf(mx, S[kb][r]);
    mx = fmaxf(mx, __shfl_xor(mx, 16)); mx = fmaxf(mx, __shfl_xor(mx, 32));
    const float mnew = fmaxf(m, mx * CS), alpha = __builtin_amdgcn_exp2f(m - mnew); m = mnew;
    float ps = 0.f;
#pragma unroll
    for (int kb = 0; kb < 4; ++kb)
#pragma unroll
        for (int r = 0; r < 4; ++r) { const float pv = __builtin_amdgcn_exp2f(S[kb][r] * CS - mnew); S[kb][r] = pv; ps += pv; }
    l = l * alpha + ps;
#pragma unroll
    for (int c = 0; c < 8; ++c) O[c] = O[c] * alpha;
}
__device__ __forceinline__ void attn_unit(const Params& p, LAS unsigned char* lds, int samp, int b, int h, int qb, float lam) {
    const int tid = threadIdx.x, lane = tid & 63, wave = __builtin_amdgcn_readfirstlane(tid >> 6), g = lane >> 4, fr = lane & 15;
    const bf16* PROJ = (const bf16*)(p.ws + WS_PROJ);
    const int rowbase = samp ? MP + b * 1024 : b * 256, NT = samp ? 20 : 4;
    const int qrow = rowbase + qb * 128 + wave * 16 + fr;
    bf16x8 Qf[4];
#pragma unroll
    for (int ds = 0; ds < 4; ++ds) Qf[ds] = *(const bf16x8*)(PROJ + (size_t)qrow * NPP + C_QA + h * 128 + 32 * ds + 8 * g);
    f32x4 O1[8], O2[8];
#pragma unroll
    for (int c = 0; c < 8; ++c) { O1[c] = (f32x4){0.f, 0.f, 0.f, 0.f}; O2[c] = (f32x4){0.f, 0.f, 0.f, 0.f}; }
    float m1 = -INFINITY, m2 = -INFINITY, l1 = 0.f, l2 = 0.f;
    v4u kr[2], vr[2];
    att_load(p, samp, b, h, 0, tid, kr, vr);
    att_store(lds, tid, kr, vr);
    __syncthreads();
    for (int t = 0; t < NT; ++t) {
        const LAS unsigned char* Kb = lds + (t & 1) * ABUF; const LAS unsigned char* Vb = Kb + KT_BYTES;
        if (t + 1 < NT) att_load(p, samp, b, h, t + 1, tid, kr, vr);
        f32x4 S1[4], S2[4];
#pragma unroll
        for (int kb = 0; kb < 4; ++kb) {
            const LAS unsigned char* kp = Kb + (16 * kb + fr) * KP + 16 * g;
            const bf16x8 k0 = *(const LAS bf16x8*)kp, k1 = *(const LAS bf16x8*)(kp + 64), k2 = *(const LAS bf16x8*)(kp + 128), k3 = *(const LAS bf16x8*)(kp + 192);
            f32x4 z = (f32x4){0.f, 0.f, 0.f, 0.f};
            S1[kb] = MFMA16(k0, Qf[0], z); S1[kb] = MFMA16(k1, Qf[1], S1[kb]);
            S2[kb] = MFMA16(k2, Qf[2], z); S2[kb] = MFMA16(k3, Qf[3], S2[kb]);
        }
        softmax_step(S1, m1, l1, O1);
        softmax_step(S2, m2, l2, O2);
        bf16x8 P1[2], P2[2];
#pragma unroll
        for (int kk = 0; kk < 2; ++kk) { P1[kk] = pack8(S1[2 * kk], S1[2 * kk + 1]); P2[kk] = pack8(S2[2 * kk], S2[2 * kk + 1]); }
        const LAS unsigned char* vb = Vb + (4 * g + (fr >> 2)) * VP + 8 * (fr & 3);
#pragma unroll
        for (int kk = 0; kk < 2; ++kk)
#pragma unroll
            for (int c = 0; c < 8; ++c) {
                const s16x4 lo = trrd(vb + kk * 32 * VP + c * 32), hi = trrd(vb + kk * 32 * VP + 16 * VP + c * 32);
                const bf16x8 vf = cat4(lo, hi);
                O1[c] = MFMA16(vf, P1[kk], O1[c]); O2[c] = MFMA16(vf, P2[kk], O2[c]);
            }
        if (t + 1 < NT) att_store(lds + ((t + 1) & 1) * ABUF, tid, kr, vr);
        __syncthreads();
    }
    l1 += __shfl_xor(l1, 16); l1 += __shfl_xor(l1, 32); l2 += __shfl_xor(l2, 16); l2 += __shfl_xor(l2, 32);
    const float i1 = 1.0f / l1, i2 = lam / l2; float ss = 0.f;
#pragma unroll
    for (int c = 0; c < 8; ++c) { O1[c] = O1[c] * i1 - O2[c] * i2; ss += (O1[c][0] * O1[c][0] + O1[c][1] * O1[c][1]) + (O1[c][2] * O1[c][2] + O1[c][3] * O1[c][3]); }
    ss += __shfl_xor(ss, 16); ss += __shfl_xor(ss, 32);
    const float rstd = (1.0f / sqrtf(ss * (1.f / 128.f) + EPS)) * 0.8f;
    bf16* A2 = (bf16*)(p.ws + WS_A2) + (size_t)qrow * D + h * 128 + 4 * g;
#pragma unroll
    for (int c = 0; c < 8; ++c) { const f32x4 dn = *(const f32x4*)(p.diff_norm + 16 * c + 4 * g); const f32x4 o = O1[c] * rstd * dn;
        v2u w; w.x = pk2(o[0], o[1]); w.y = pk2(o[2], o[3]); *(v2u*)(A2 + 16 * c) = w; }
}

constexpr int QP = 144, VP2 = 288;
constexpr int GI_QT = 0, GI_KT = 64 * QP, GI_VT = 2 * 64 * QP, GI_WG = GI_VT + 64 * VP2, GI_BG = GI_WG + 32768;
constexpr size_t WS_BL = 27 * MiB + 256 * 1024, WS_VT = WS_XN;
__device__ __forceinline__ float logsig(float x) { return fminf(x, 0.f) - __logf(1.f + __expf(-fabsf(x))); }
__device__ __forceinline__ void gla_decode(int item, int& samp, int& b, int& h, int& dir, int& ch) {
    if (item < 1024) { samp = 1; ch = item & 15; dir = (item >> 4) & 1; h = (item >> 5) & 3; b = item >> 7; }
    else { const int i = item - 1024; samp = 0; ch = i & 3; dir = (i >> 2) & 1; h = (i >> 3) & 3; b = i >> 5; }
}
struct GiIn { f32x4 g0, g1, g2, g3; v4u qw, kw, vw0, vw1; };
__device__ __forceinline__ void gi_load(const Params& p, int item, GiIn& I) {
    const int tid = threadIdx.x, lane = tid & 63, wave = __builtin_amdgcn_readfirstlane(tid >> 6);
    int samp, b, h, dir, ch; gla_decode(item, samp, b, h, dir, ch);
    const bf16* PROJ = (const bf16*)(p.ws + WS_PROJ); const float* GATE = (const float*)(p.ws + WS_GATE);
    const int L = samp ? 1024 : 256, rowbase = samp ? MP + b * 1024 : b * 256;
    const int tpos0 = ch * 64 + lane, tok0 = dir ? (L - 1 - tpos0) : tpos0, row0 = rowbase + tok0;
    const float* gp = GATE + (size_t)row0 * 32 + dir * 16;
    I.g0 = *(const f32x4*)gp; I.g1 = *(const f32x4*)(gp + 4); I.g2 = *(const f32x4*)(gp + 8); I.g3 = *(const f32x4*)(gp + 12);
    const bf16* rp = PROJ + (size_t)row0 * NPP;
    I.qw = *(const v4u*)(rp + C_QB + h * 64 + 8 * wave); I.kw = *(const v4u*)(rp + C_KB + h * 64 + 8 * wave);
    I.vw0 = *(const v4u*)(rp + C_VB + h * 128 + 8 * wave); I.vw1 = *(const v4u*)(rp + C_VB + h * 128 + 64 + 8 * wave);
}
__device__ __forceinline__ void gla_intra(const Params& p, LAS unsigned char* lds, int item, const GiIn& I) {
    const int tid = threadIdx.x, lane = tid & 63, wave = __builtin_amdgcn_readfirstlane(tid >> 6), g = lane >> 4, fr = lane & 15;
    int samp, b, h, dir, ch; gla_decode(item, samp, b, h, dir, ch);
    bf16* OG = (bf16*)(p.ws + (dir ? WS_OGB : WS_OGF));
    bf16* QT = (bf16*)p.out + (size_t)item * 4096; bf16* KH = (bf16*)p.out + (size_t)8388608 + (size_t)item * 4096;
    bf16* VT = (bf16*)(p.ws + WS_VT) + (size_t)item * 8192; float* BLg = (float*)(p.ws + WS_BL) + item * 64;
    const int L = samp ? 1024 : 256, rowbase = samp ? MP + b * 1024 : b * 256;
    LAS float* WgL = (LAS float*)(lds + GI_WG) + (dir * 4 + h) * 1024; LAS float* BgL = (LAS float*)(lds + GI_BG) + (dir * 4 + h) * 64;
    const f32x4 g0 = I.g0, g1 = I.g1, g2 = I.g2, g3 = I.g3; const v4u qw = I.qw, kw = I.kw, vw0 = I.vw0, vw1 = I.vw1;
    {
        float gl[16] = {g0[0], g0[1], g0[2], g0[3], g1[0], g1[1], g1[2], g1[3], g2[0], g2[1], g2[2], g2[3], g3[0], g3[1], g3[2], g3[3]};
        float x[8];
#pragma unroll
        for (int e = 0; e < 8; ++e) x[e] = BgL[8 * wave + e];
#pragma unroll
        for (int j = 0; j < 16; ++j) { const f32x4 wa = *(const LAS f32x4*)(WgL + j * 64 + 8 * wave), wb = *(const LAS f32x4*)(WgL + j * 64 + 8 * wave + 4);
#pragma unroll
            for (int e = 0; e < 4; ++e) { x[e] += gl[j] * wa[e]; x[4 + e] += gl[j] * wb[e]; } }
        float qf[8], kf[8];
#pragma unroll
        for (int e = 0; e < 4; ++e) { const unsigned a = qw[e], bb = kw[e]; qf[2 * e] = bflo(a); qf[2 * e + 1] = bfhi(a); kf[2 * e] = bflo(bb); kf[2 * e + 1] = bfhi(bb); }
        float qt[8], kt[8];
#pragma unroll
        for (int e = 0; e < 8; ++e) {
            float v = logsig(x[e]) * (1.f / 16.f);
#pragma unroll
            for (int o = 1; o < 64; o <<= 1) { const float u = __shfl_up(v, o); if (lane >= o) v += u; }
            const float blast = __shfl(v, 63);
            qt[e] = qf[e] * 0.125f * __expf(v); kt[e] = kf[e] * __expf(-v);
            KH[(8 * wave + e) * 64 + lane] = (bf16)f2bf(kf[e] * __expf(blast - v));
            if (lane == 63) BLg[8 * wave + e] = __expf(blast);
        }
        v4u w;
        w.x = pk2(qt[0], qt[1]); w.y = pk2(qt[2], qt[3]); w.z = pk2(qt[4], qt[5]); w.w = pk2(qt[6], qt[7]);
        *(LAS v4u*)(lds + GI_QT + lane * QP + 16 * wave) = w; *(v4u*)(QT + lane * 64 + 8 * wave) = w;
        w.x = pk2(kt[0], kt[1]); w.y = pk2(kt[2], kt[3]); w.z = pk2(kt[4], kt[5]); w.w = pk2(kt[6], kt[7]); *(LAS v4u*)(lds + GI_KT + lane * QP + 16 * wave) = w;
        *(LAS v4u*)(lds + GI_VT + lane * VP2 + 16 * wave) = vw0; *(LAS v4u*)(lds + GI_VT + lane * VP2 + 128 + 16 * wave) = vw1;
#pragma unroll
        for (int e = 0; e < 4; ++e) {
            VT[(8 * wave + 2 * e) * 64 + lane] = (bf16)(vw0[e] & 0xffffu); VT[(8 * wave + 2 * e + 1) * 64 + lane] = (bf16)(vw0[e] >> 16);
            VT[(64 + 8 * wave + 2 * e) * 64 + lane] = (bf16)(vw1[e] & 0xffffu); VT[(64 + 8 * wave + 2 * e + 1) * 64 + lane] = (bf16)(vw1[e] >> 16);
        }
    }
    __syncthreads();
    {
        const int a = wave >> 1, half = wave & 1;
        f32x4 at[4];
#pragma unroll
        for (int sb = 0; sb < 4; ++sb) {
            at[sb] = (f32x4){0.f, 0.f, 0.f, 0.f};
            if (sb <= a) {
#pragma unroll
                for (int ks = 0; ks < 2; ++ks) { const bf16x8 kfr = *(const LAS bf16x8*)(lds + GI_KT + (16 * sb + fr) * QP + 64 * ks + 16 * g);
                    const bf16x8 qfr = *(const LAS bf16x8*)(lds + GI_QT + (16 * a + fr) * QP + 64 * ks + 16 * g);
                    at[sb] = MFMA16(kfr, qfr, at[sb]); }
                if (sb == a) {
#pragma unroll
                    for (int r = 0; r < 4; ++r) if (4 * g + r > fr) at[sb][r] = 0.f; }
            }
        }
        const bf16x8 pa0 = pack8(at[0], at[1]), pa1 = pack8(at[2], at[3]);
#pragma unroll
        for (int cc = 0; cc < 4; ++cc) {
            const int c = 4 * half + cc;
            const LAS unsigned char* vtb = lds + GI_VT + 32 * c + 8 * (fr & 3) + (4 * g + (fr >> 2)) * VP2;
            f32x4 o = (f32x4){0.f, 0.f, 0.f, 0.f};
            { const s16x4 lo = trrd(vtb), hi = trrd(vtb + 16 * VP2); o = MFMA16(pa0, cat4(lo, hi), o); }
            if (a >= 2) { const s16x4 lo = trrd(vtb + 32 * VP2), hi = trrd(vtb + 48 * VP2); o = MFMA16(pa1, cat4(lo, hi), o); }
#pragma unroll
            for (int r = 0; r < 4; ++r) { const int tpos = ch * 64 + 16 * a + 4 * g + r, tok = dir ? (L - 1 - tpos) : tpos;
                OG[(size_t)(rowbase + tok) * 512 + h * 128 + 16 * c + fr] = (bf16)f2bf(o[r]); }
        }
    }
    __syncthreads();
}

struct GbRegs { v4u q, k; f32x4 bl; v4u vt0, vt1; };
constexpr int GB_SLOT = 2 * 64 * QP + 256;
__device__ __forceinline__ void gb_ld(const Params& p, GbRegs& R, int item, int c, int g, int fr, int tid) {
    const bf16* QT = (const bf16*)p.out + (size_t)item * 4096; const bf16* KH = (const bf16*)p.out + (size_t)8388608 + (size_t)item * 4096;
    const bf16* VT = (const bf16*)(p.ws + WS_VT) + (size_t)item * 8192; const float* BLg = (const float*)(p.ws + WS_BL) + item * 64;
    R.q = *(const v4u*)(QT + tid * 8); R.k = *(const v4u*)(KH + tid * 8); R.bl = *(const f32x4*)(BLg + (tid & 15) * 4);
    R.vt0 = *(const v4u*)(VT + (16 * c + fr) * 64 + 8 * g); R.vt1 = *(const v4u*)(VT + (16 * c + fr) * 64 + 32 + 8 * g);
}
__device__ __forceinline__ void gb_st(LAS unsigned char* slot, const GbRegs& R, int tid) {
    *(LAS v4u*)(slot + (tid >> 3) * QP + (tid & 7) * 16) = R.q; *(LAS v4u*)(slot + 64 * QP + (tid >> 3) * QP + (tid & 7) * 16) = R.k;
    if (tid < 16) *(LAS f32x4*)(slot + 2 * 64 * QP + tid * 16) = R.bl;
}
__device__ __forceinline__ void gb_step(const LAS unsigned char* slot, f32x4 (&S)[4], const v4u vt0, const v4u vt1, bf16* ogb, int oidx, int tstep, int g, int fr) {
    const bf16x8 sb0 = pack8(S[0], S[1]), sb1 = pack8(S[2], S[3]);
#pragma unroll
    for (int a = 0; a < 4; ++a) {
        const LAS unsigned char* qp = slot + (16 * a + fr) * QP + 8 * g;
        const v2u l0 = *(const LAS v2u*)qp, h0 = *(const LAS v2u*)(qp + 32), l1 = *(const LAS v2u*)(qp + 64), h1 = *(const LAS v2u*)(qp + 96);
        f32x4 o = (f32x4){0.f, 0.f, 0.f, 0.f};
        { const v4u aw = (v4u){l0.x, l0.y, h0.x, h0.y}; o = MFMA16(__builtin_bit_cast(bf16x8, aw), sb0, o); }
        { const v4u aw = (v4u){l1.x, l1.y, h1.x, h1.y}; o = MFMA16(__builtin_bit_cast(bf16x8, aw), sb1, o); }
#pragma unroll
        for (int r = 0; r < 4; ++r) ogb[oidx + (16 * a + r) * tstep] = (bf16)f2bf(o[r]);
    }
#pragma unroll
    for (int kb = 0; kb < 4; ++kb) {
        const f32x4 bl = *(const LAS f32x4*)(slot + 2 * 64 * QP + (16 * kb + 4 * g) * 4);
        const LAS unsigned char* kp = slot + 64 * QP + (16 * kb + fr) * QP + 16 * g;
        const bf16x8 k0 = *(const LAS bf16x8*)kp, k1 = *(const LAS bf16x8*)(kp + 64);
        S[kb] = S[kb] * bl;
        S[kb] = MFMA16(k0, __builtin_bit_cast(bf16x8, vt0), S[kb]);
        S[kb] = MFMA16(k1, __builtin_bit_cast(bf16x8, vt1), S[kb]);
    }
}
__device__ __forceinline__ void gla_chain(const Params& p, LAS unsigned char* lds, int samp, int b, int h, int dir) {
    const int tid = threadIdx.x, lane = tid & 63, g = lane >> 4, fr = lane & 15, c = __builtin_amdgcn_readfirstlane(tid >> 6);
    const int L = samp ? 1024 : 256, NC = L / 64, rowbase = samp ? MP + b * 1024 : b * 256;
    const int item0 = samp ? (((b * 4 + h) * 2 + dir) * 16) : (1024 + ((b * 4 + h) * 2 + dir) * 4);
    bf16* ogb = (bf16*)p.out + (size_t)(dir ? 25165824 : 16777216);
    const int tstep = dir ? -512 : 512;
    f32x4 S[4];
    if (samp) { const float* st = (dir ? p.state_b : p.state_f) + (size_t)(b * 4 + h) * 64 * 128 + 16 * c + fr;
#pragma unroll
        for (int kb = 0; kb < 4; ++kb)
#pragma unroll
            for (int r = 0; r < 4; ++r) S[kb][r] = st[(16 * kb + 4 * g + r) * 128]; }
    else {
#pragma unroll
        for (int kb = 0; kb < 4; ++kb) S[kb] = (f32x4){0.f, 0.f, 0.f, 0.f}; }
    int oidx = (rowbase + (dir ? (L - 1) : 0)) * 512 + 4 * g * tstep + h * 128 + 16 * c + fr;
    GbRegs R0, R1;
    gb_ld(p, R0, item0, c, g, fr, tid); gb_ld(p, R1, item0 + 1, c, g, fr, tid);
    for (int ch = 0; ch < NC; ch += 2) {
        { gb_st(lds, R0, tid); __syncthreads(); const v4u a0 = R0.vt0, a1 = R0.vt1;
          if (ch + 2 < NC) gb_ld(p, R0, item0 + ch + 2, c, g, fr, tid);
          gb_step(lds, S, a0, a1, ogb, oidx, tstep, g, fr); oidx += 64 * tstep; }
        { gb_st(lds + GB_SLOT, R1, tid); __syncthreads(); const v4u a0 = R1.vt0, a1 = R1.vt1;
          if (ch + 3 < NC) gb_ld(p, R1, item0 + ch + 3, c, g, fr, tid);
          gb_step(lds + GB_SLOT, S, a0, a1, ogb, oidx, tstep, g, fr); oidx += 64 * tstep; }
    }
    __syncthreads();
    if (!samp) {
        float* so = p.out + (dir ? O_SB : O_SF) + (size_t)(b * 4 + h) * 64 * 128 + 16 * c + fr;
#pragma unroll
        for (int kb = 0; kb < 4; ++kb)
#pragma unroll
            for (int r = 0; r < 4; ++r) so[(16 * kb + 4 * g + r) * 128] = S[kb][r];
    }
}
__device__ __forceinline__ void phase_gla_inter(const Params& p, LAS unsigned char* lds) {
    for (int rep = 0; rep < REP_GLA; ++rep) {
        if (gridDim.x == 256) {
            const int u = blockIdx.x;
            if (u < 64) gla_chain(p, lds, 1, u >> 3, (u >> 1) & 3, u & 1);
            else { for (int v = u - 64; v < 256; v += 192) gla_chain(p, lds, 0, v >> 3, (v >> 1) & 3, v & 1); }
        } else {
            for (int u = blockIdx.x; u < 320; u += gridDim.x) { if (u < 64) gla_chain(p, lds, 1, u >> 3, (u >> 1) & 3, u & 1); else { const int v = u - 64; gla_chain(p, lds, 0, v >> 3, (v >> 1) & 3, v & 1); } }
        }
    }
}

__device__ __forceinline__ void phase3(const Params& p, LAS unsigned char* lds) {
    const int lane = threadIdx.x & 63;
    float lam;
    { const float a = wave_sum(p.lq1[lane] * p.lk1[lane]), b = wave_sum(p.lq2[lane] * p.lk2[lane]); lam = __expf(a) - __expf(b) + 0.2f; }
    {
        const int tid = threadIdx.x;
        LAS float* WgL = (LAS float*)(lds + GI_WG); LAS float* BgL = (LAS float*)(lds + GI_BG);
        for (int i = tid; i < 8192; i += NTHR) { const int dh = i >> 10, j = (i >> 6) & 15, k = i & 63; WgL[i] = ((dh >> 2) ? p.wg_b : p.wg_f)[j * 256 + (dh & 3) * 64 + k]; }
        { const int dh = tid >> 6, k = tid & 63; BgL[tid] = ((dh >> 2) ? p.bg_b : p.bg_f)[(dh & 3) * 64 + k]; }
        GiIn IA, IB; const int G = gridDim.x; int it = blockIdx.x;
        if (it < 2048) gi_load(p, it, IA);
        __syncthreads();
        for (; it < 2048; it += 2 * G) {
            const int it2 = it + G, it3 = it2 + G;
            if (it2 < 2048) gi_load(p, it2, IB);
            gla_intra(p, lds, it, IA);
            if (it3 < 2048) gi_load(p, it3, IA);
            if (it2 < 2048) gla_intra(p, lds, it2, IB);
        }
    }
    for (int rep = 0; rep < REP_ATT; ++rep) {
    for (int u = blockIdx.x; u < 256; u += gridDim.x) attn_unit(p, lds, 0, u >> 3, (u >> 1) & 3, u & 1, lam);
    for (int u = blockIdx.x; u < 256; u += gridDim.x) attn_unit(p, lds, 1, u >> 5, (u >> 3) & 3, u & 7, lam);
    }
}


__device__ __forceinline__ void phase3b(const Params& p) {
    const int tid = threadIdx.x, lane = tid & 63, wave = tid >> 6;
    const bf16* PROJ = (const bf16*)(p.ws + WS_PROJ); const bf16* OGF = (const bf16*)(p.ws + WS_OGF); const bf16* OGB = (const bf16*)(p.ws + WS_OGB);
    bf16* A2 = (bf16*)(p.ws + WS_A2);
    const int gw = blockIdx.x * NWAVES + wave, NGW = gridDim.x * NWAVES;
    const f32x4 n0 = *(const f32x4*)(p.gla_norm + 8 * (lane & 15)), n1 = *(const f32x4*)(p.gla_norm + 8 * (lane & 15) + 4);
    for (int row = gw; row < M; row += NGW) {
        const v4u a = *(const v4u*)(OGF + (size_t)row * 512 + 8 * lane), bq = *(const v4u*)(OGB + (size_t)row * 512 + 8 * lane);
        const v4u a2 = *(const v4u*)((const bf16*)p.out + (size_t)16777216 + (size_t)row * 512 + 8 * lane), b2 = *(const v4u*)((const bf16*)p.out + (size_t)25165824 + (size_t)row * 512 + 8 * lane);
        const v4u rw = *(const v4u*)(PROJ + (size_t)row * NPP + C_RB + 8 * lane);
        float o[8], rr[8]; float ss = 0.f;
#pragma unroll
        for (int e = 0; e < 4; ++e) { o[2 * e] = (bflo(a[e]) + bflo(bq[e])) + (bflo(a2[e]) + bflo(b2[e])); o[2 * e + 1] = (bfhi(a[e]) + bfhi(bq[e])) + (bfhi(a2[e]) + bfhi(b2[e])); rr[2 * e] = bflo(rw[e]); rr[2 * e + 1] = bfhi(rw[e]); }
#pragma unroll
        for (int e = 0; e < 8; ++e) ss += o[e] * o[e];
        ss += __shfl_xor(ss, 1); ss += __shfl_xor(ss, 2); ss += __shfl_xor(ss, 4); ss += __shfl_xor(ss, 8);
        const float rstd = 1.0f / sqrtf(ss * (1.f / 128.f) + EPS);
        float y[8];
#pragma unroll
        for (int e = 0; e < 8; ++e) { const float nw = e < 4 ? n0[e] : n1[e - 4]; const float sl = rr[e] / (1.f + __expf(-rr[e])); y[e] = o[e] * rstd * nw * sl; }
        v4u w; w.x = pk2(y[0], y[1]); w.y = pk2(y[2], y[3]); w.z = pk2(y[4], y[5]); w.w = pk2(y[6], y[7]);
        *(v4u*)(A2 + (size_t)row * D + 512 + 8 * lane) = w;
    }
}

__device__ __forceinline__ void phase5(const Params& p) {
    const int tid = threadIdx.x, lane = tid & 63, wave = tid >> 6;
    const float* MOD = (const float*)(p.ws + WS_MOD); bf16* XN = (bf16*)(p.ws + WS_XN); const float* MIX = (const float*)(p.ws + WS_MIX);
    const int gw = blockIdx.x * NWAVES + wave, NGW = gridDim.x * NWAVES;
    for (int row = gw; row < M; row += NGW) {
        const float* xr = row < MP ? p.xp + (size_t)row * D : p.xs + (size_t)(row - MP) * D;
        const int r = row < MP ? 0 : 1 + ((row - MP) >> 10);
        const float* mr = MOD + r * 6144;
        f32x4 v[4], mv[4]; float s2 = 0.f;
#pragma unroll
        for (int j = 0; j < 4; ++j) { mv[j] = ((const f32x4*)(MIX + (size_t)row * D))[lane + 64 * j]; v[j] = ((const f32x4*)xr)[lane + 64 * j]; s2 += (mv[j][0] * mv[j][0] + mv[j][1] * mv[j][1]) + (mv[j][2] * mv[j][2] + mv[j][3] * mv[j][3]); }
        const float rstd = 1.0f / sqrtf(wave_sum(s2) * (1.f / D) + EPS);
        float t2 = 0.f;
#pragma unroll
        for (int j = 0; j < 4; ++j) { const int q = lane + 64 * j;
            const f32x4 gp = ((const f32x4*)p.g_attn_post)[q], ga = ((const f32x4*)(mr + 2048))[q];
            v[j] = v[j] + ga * (mv[j] * rstd * gp);
            ((f32x4*)(p.out + O_Y + (size_t)row * D))[q] = v[j];
            t2 += (v[j][0] * v[j][0] + v[j][1] * v[j][1]) + (v[j][2] * v[j][2] + v[j][3] * v[j][3]); }
        const float rstd2 = 1.0f / sqrtf(wave_sum(t2) * (1.f / D) + EPS);
#pragma unroll
        for (int j = 0; j < 4; ++j) { const int q = lane + 64 * j;
            const f32x4 g = ((const f32x4*)p.g_mlp_pre)[q], sh = ((const f32x4*)(mr + 3072))[q], sc = ((const f32x4*)(mr + 4096))[q];
            const f32x4 h = (v[j] * rstd2 * g) * (sc + 1.0f) + sh;
            v2u w; w.x = pk2(h[0], h[1]); w.y = pk2(h[2], h[3]); ((v2u*)(XN + (size_t)row * D))[q] = w; }
    }
}
__device__ __forceinline__ void phase8(const Params& p) {
    const int tid = threadIdx.x, lane = tid & 63, wave = tid >> 6;
    const float* MOD = (const float*)(p.ws + WS_MOD); const float* F = (const float*)(p.ws + WS_F);
    const int gw = blockIdx.x * NWAVES + wave, NGW = gridDim.x * NWAVES;
    for (int row = gw; row < M; row += NGW) {
        const int r = row < MP ? 0 : 1 + ((row - MP) >> 10);
        const float* mr = MOD + r * 6144; float* yr = p.out + O_Y + (size_t)row * D;
        f32x4 v[4], fv[4]; float s2 = 0.f;
#pragma unroll
        for (int j = 0; j < 4; ++j) { fv[j] = ((const f32x4*)(F + (size_t)row * D))[lane + 64 * j]; v[j] = ((const f32x4*)yr)[lane + 64 * j]; s2 += (fv[j][0] * fv[j][0] + fv[j][1] * fv[j][1]) + (fv[j][2] * fv[j][2] + fv[j][3] * fv[j][3]); }
        const float rstd = 1.0f / sqrtf(wave_sum(s2) * (1.f / D) + EPS);
#pragma unroll
        for (int j = 0; j < 4; ++j) { const int q = lane + 64 * j;
            const f32x4 gp = ((const f32x4*)p.g_mlp_post)[q], ga = ((const f32x4*)(mr + 5120))[q];
            ((f32x4*)yr)[q] = v[j] + ga * (fv[j] * rstd * gp); }
    }
}

#define RLX_AGENT __ATOMIC_RELAXED, __HIP_MEMORY_SCOPE_AGENT
#define XB_TMO      128
#define XB_XCNT(j)  (256  + 64 * (j))
#define XB_XSUB(j)  (1280 + 64 * (j))
#define XB_XGEN(j)  (2304 + 64 * (j))
#define XB_TOP      3328
#define XB_TOPGEN   3392
#define XCD_BAR_WORDS 3456
#define XB_SPIN_CAP (1u << 18)

__device__ __forceinline__ unsigned xb_ld(unsigned* p)              { return __hip_atomic_load(p, __ATOMIC_RELAXED, __HIP_MEMORY_SCOPE_AGENT); }
__device__ __forceinline__ unsigned xb_add(unsigned* p, unsigned v) { return __hip_atomic_fetch_add(p, v, __ATOMIC_RELAXED, __HIP_MEMORY_SCOPE_AGENT); }
__device__ __forceinline__ unsigned xb_xcc_id() { return (unsigned)__builtin_amdgcn_s_getreg((3 << 11) | 20) & 0xFu; }
#define XB_SPIN(cond, bar) do { unsigned _sp = 0; while (cond) { __builtin_amdgcn_s_sleep(1); \
    if ((++_sp & 255u) == 0u) { if (xb_ld(&(bar)[XB_TMO])) break; if (_sp > XB_SPIN_CAP) { atomicAdd(&(bar)[XB_TMO], 1u); break; } } } } while (0)

struct XcdBarrier {
    unsigned* bar; unsigned x;
    volatile LAS unsigned* st;
};

__device__ __forceinline__ XcdBarrier xcd_barrier_post(unsigned* bar, volatile LAS unsigned* st) {
    XcdBarrier b; b.bar = bar; b.x = xb_xcc_id(); b.st = st;
    if (threadIdx.x == 0) (void)xb_add(&bar[XB_XCNT(b.x)], 1u);
    return b;
}
__device__ __forceinline__ void xcd_barrier_complete(unsigned* bar, unsigned x, unsigned& nloc, unsigned& nx) {
    const unsigned G = gridDim.x * gridDim.y * gridDim.z;
    unsigned sum, cnt, mine, sp = 0u;
    for (;;) {
        sum = 0u; cnt = 0u; mine = 0u;
#pragma unroll
        for (unsigned j = 0; j < 16; ++j) { const unsigned c = xb_ld(&bar[XB_XCNT(j)]); sum += c; cnt += (c > 0u) ? 1u : 0u; mine = (j == x) ? c : mine; }
        if (sum == G) break;
        __builtin_amdgcn_s_sleep(1);
        if ((++sp & 255u) == 0u) { if (xb_ld(&bar[XB_TMO])) break; if (sp > XB_SPIN_CAP) { atomicAdd(&bar[XB_TMO], 1u); break; } }
    }
    nloc = mine > 0u ? mine : 1u; nx = cnt > 0u ? cnt : 1u;
}

__device__ __forceinline__ void xcd_barrier(const XcdBarrier& b) {
    asm volatile("s_waitcnt vmcnt(0)" ::: "memory");
    __syncthreads();
    if (threadIdx.x == 0) {
        unsigned* bar = b.bar;
        __builtin_amdgcn_s_waitcnt(0);
        unsigned nloc = b.st[0], nx = b.st[1];
        if (nloc == 0u) { xcd_barrier_complete(bar, b.x, nloc, nx); b.st[0] = nloc; b.st[1] = nx; }
        const unsigned old = xb_add(&bar[XB_XSUB(b.x)], 1u);
        const unsigned gen = old / nloc;
        if (old + 1u == (gen + 1u) * nloc) {
            __builtin_amdgcn_fence(__ATOMIC_RELEASE, "agent");
            asm volatile("s_waitcnt vmcnt(0)" ::: "memory");
            const unsigned og = xb_add(&bar[XB_TOP], 1u);
            const unsigned tg = og / nx;
            if (og + 1u == (tg + 1u) * nx) xb_add(&bar[XB_TOPGEN], 1u);
            else XB_SPIN(xb_ld(&bar[XB_TOPGEN]) == tg, bar);
            __builtin_amdgcn_fence(__ATOMIC_ACQUIRE, "agent");
            xb_add(&bar[XB_XGEN(b.x)], 1u);
            asm volatile("s_waitcnt vmcnt(0)" ::: "memory");
        } else {
            XB_SPIN(xb_ld(&bar[XB_XGEN(b.x)]) == gen, bar);
            __builtin_amdgcn_fence(__ATOMIC_ACQUIRE, "agent");
            asm volatile("s_waitcnt vmcnt(0)" ::: "memory");
        }
    }
    __syncthreads();
}

constexpr int N_PHASES = 9;
__global__ void __launch_bounds__(NTHR, 2) fwd_megakernel(Params p) {
    extern __shared__ __attribute__((aligned(16))) unsigned char lds_raw[];
    LAS unsigned char* lds = (LAS unsigned char*)lds_raw;
    cg::grid_group grid = cg::this_grid();
    unsigned char* ws = p.ws;
    const int lo = p.ph_lo, hi = p.ph_hi;
    for (int u = threadIdx.x; u < 64; u += NTHR) ((LAS unsigned*)(lds + 131072))[u] = 0u;
    __syncthreads();
    XcdBarrier bar = xcd_barrier_post((unsigned*)ws + 4096, (volatile LAS unsigned*)(lds + 131072));
#define IN(k) (lo <= (k) && (k) < hi)
#ifndef REP_SYNC
#define REP_SYNC 1
#endif
#define SEAM(k) do { if (IN(k) && IN((k) + 1)) { for (int rs = 0; rs < REP_SYNC; ++rs) { if (USE_CG_SYNC || p.ph_lo == 12345) grid.sync(); else xcd_barrier(bar); } } } while (0)
    if (IN(0)) { for (int rep = 0; rep < REP_P0; ++rep) { phase0(p, lds); __syncthreads(); } } SEAM(0);
    if (IN(1)) { phase1(p); } SEAM(1);
    if (IN(2)) _Pragma("unroll") for (int rep = 0; rep < REP_P2; ++rep) {
        pg8::Gemm gm{(const bf16*)(ws + WS_XN), (const bf16*)(ws + WS_WIN), M, 3072, D}; pg8::StaticOrder S; S.init(M, 3072, gridDim.x, (int)blockIdx.x);
        pg8::EpiInProj E{(bf16*)(ws + WS_PROJ), (float*)(ws + WS_GATE), p.out + O_NK, p.out + O_NV, (const float*)(ws + WS_ROPE), (const float*)(ws + WS_ROPE) + 1024};
        pg8::gemm_phase<pg8::EpiInProj, pg8::StaticOrder, true, true>(lds, gm, S, E);
        gate_gemm(p, lds);
    } SEAM(2);
    if (IN(3)) { phase3(p, lds); } SEAM(3);
    if (IN(4)) { phase_gla_inter(p, lds); if (IN(5)) xcd_barrier(bar); phase3b(p); } SEAM(4);
    if (IN(5)) _Pragma("unroll") for (int rep = 0; rep < REP_P5; ++rep) {
        pg8::Gemm gm{(const bf16*)(ws + WS_A2), (const bf16*)(ws + WS_WOUT), M, D, D}; pg8::StaticOrder S; S.init(M, D, gridDim.x, (int)blockIdx.x);
        pg8::EpiF32 E{(float*)(ws + WS_MIX), D};
        pg8::gemm_phase<pg8::EpiF32, pg8::StaticOrder, true, true>(lds, gm, S, E);
    } SEAM(5);
    if (IN(6)) { phase5(p); } SEAM(6);
    if (IN(7)) _Pragma("unroll") for (int rep = 0; rep < REP_P7; ++rep) {
        pg8::Gemm gm{(const bf16*)(ws + WS_XN), (const bf16*)(ws + WS_W1), M, FF, D}; pg8::StaticOrder S; S.init(M, FF, gridDim.x, (int)blockIdx.x);
        pg8::EpiRelu2 E{(bf16*)(ws + WS_H), FF};
        pg8::gemm_phase<pg8::EpiRelu2, pg8::StaticOrder, true, true>(lds, gm, S, E);
    } SEAM(7);
    if (IN(8)) _Pragma("unroll") for (int rep = 0; rep < REP_P8; ++rep) {
        pg8::Gemm gm{(const bf16*)(ws + WS_H), (const bf16*)(ws + WS_W2), M, D, FF}; pg8::StaticOrder S; S.init(M, D, gridDim.x, (int)blockIdx.x);
        pg8::EpiF32 E{(float*)(ws + WS_F), D};
        pg8::gemm_phase<pg8::EpiF32, pg8::StaticOrder, true, true>(lds, gm, S, E);
    } SEAM(8);
    if (IN(9)) { phase8(p); }
#undef IN
#undef SEAM
}

extern "C" void kernel_launch(void* const* d_in, const int* in_sizes, int n_in, void* d_out, int out_size, void* d_ws, size_t ws_size, hipStream_t stream) {
    static int grid = 0;
    if (grid == 0) {
        int dev = 0, cus = 0, per_cu = 0;
        hipGetDevice(&dev); hipDeviceGetAttribute(&cus, hipDeviceAttributeMultiprocessorCount, dev);
        if (hipFuncSetAttribute((const void*)fwd_megakernel, hipFuncAttributeMaxDynamicSharedMemorySize, LDS_BYTES) != hipSuccess) { fprintf(stderr, "hipFuncSetAttribute failed\n"); }
        if (hipOccupancyMaxActiveBlocksPerMultiprocessor(&per_cu, (const void*)fwd_megakernel, NTHR, LDS_BYTES) != hipSuccess || per_cu < 1) { fprintf(stderr, "occupancy query: %d\n", per_cu); per_cu = 1; }
        (void)hipGetLastError();
        grid = cus * 1;
        if (grid <= 0) grid = 256;
    }
    if (hipMemsetAsync(d_ws, 0, 65536, stream) != hipSuccess) fprintf(stderr, "memset failed\n");
    Params p{};
    const float* const* in = (const float* const*)d_in;
    p.xp = in[0]; p.xs = in[1]; p.c = in[2]; p.cache_k = in[3]; p.cache_v = in[4]; p.state_f = in[5]; p.state_b = in[6]; p.c_ctx = in[7]; p.w_ada = in[8]; p.b_ada = in[9];
    p.g_attn_pre = in[10]; p.g_attn_post = in[11]; p.g_mlp_pre = in[12]; p.g_mlp_post = in[13]; p.w_in = in[14]; p.wg_f = in[15]; p.bg_f = in[16]; p.wg_b = in[17]; p.bg_b = in[18];
    p.lq1 = in[19]; p.lk1 = in[20]; p.lq2 = in[21]; p.lk2 = in[22]; p.diff_norm = in[23]; p.gla_norm = in[24]; p.w_out = in[25]; p.w_mlp1 = in[26]; p.w_mlp2 = in[27];
    p.out = (float*)d_out; p.ws = (unsigned char*)d_ws;
#if MK_N_LAUNCHES == 1
    p.ph_lo = 0; p.ph_hi = N_PHASES + 1;
    void* args[] = {&p};
    hipError_t e = hipLaunchCooperativeKernel((const void*)fwd_megakernel, dim3(grid), dim3(NTHR), args, LDS_BYTES, stream);
    if (e != hipSuccess) fprintf(stderr, "cooperative launch failed: %s (grid %d)\n", hipGetErrorString(e), grid);
#else
    for (int k = 0; k <= N_PHASES; ++k) { p.ph_lo = k; p.ph_hi = k + 1; hipLaunchKernelGGL(fwd_megakernel, dim3(grid), dim3(NTHR), LDS_BYTES, stream, p); }
#endif
}
```
